# Optimizing an MI355X kernel written in HIP

```python
import math
import jax, jax.numpy as jnp
from jax import lax
import numpy as np

D_MODEL = 1024
BATCH = 8
SEQ = 2048
DEPTH = 2
DEC_BATCH = 128
DEC_SEQ = 4
PAST_LEN = 16384
PAGE_SIZE = 128

N_MIXERS = 2
GLA_HEADS = 4
GLA_DK = D_MODEL // 2
GLA_DV = D_MODEL
GLA_DK_HEAD = GLA_DK // GLA_HEADS
GLA_DV_HEAD = GLA_DV // GLA_HEADS
GLA_GATE_RANK = 16
GLA_TAU = 16.0
GLA_CHUNK = 64
GLA_IN = 2 * GLA_DK + 2 * GLA_DV + GLA_GATE_RANK
CONV_WIDTH = 3
D_FF = 4 * D_MODEL
N_GLA = (DEPTH + 1) // 2
N_CONV = DEPTH // 2
ALPHA = (2 * DEPTH) ** 0.25
BETA = (8 * DEPTH) ** -0.25
LN_EPS = 1e-5
RMS_EPS = 1e-6

kernel_name = "gla_shortconv_hybrid_step"


def layer_norm(x, g, b):
    xf = x.astype(jnp.float32)
    mu = jnp.mean(xf, axis=-1, keepdims=True)
    var = jnp.mean(jnp.square(xf - mu), axis=-1, keepdims=True)
    return ((xf - mu) * lax.rsqrt(var + LN_EPS) * g.astype(jnp.float32) + b.astype(jnp.float32)).astype(x.dtype)


def gla_core(q, k, v, g, s0):
    bsz, t, nh, dk = q.shape
    dv = v.shape[-1]
    c = GLA_CHUNK if t % GLA_CHUNK == 0 else t
    n = t // c

    def blk(a):
        return a.reshape(bsz, n, c, nh, a.shape[-1]).transpose(0, 3, 1, 2, 4)

    q, k, v, g = blk(q), blk(k), blk(v), blk(g)
    b = jnp.cumsum(g, axis=3)
    b_last = b[..., -1:, :]
    q_dec = q * jnp.exp(b)
    k_dec = k * jnp.exp(-b)
    causal = jnp.tril(jnp.ones((c, c), dtype=bool))
    scores = jnp.where(causal, jnp.einsum('bhnid,bhnjd->bhnij', q_dec, k_dec), 0.0)
    o_intra = jnp.einsum('bhnij,bhnjv->bhniv', scores, v)
    kv = jnp.einsum('bhncd,bhncv->nbhdv', k * jnp.exp(b_last - b), v)
    decay = jnp.exp(b_last[..., 0, :]).transpose(2, 0, 1, 3)

    def step(s, inp):
        dec, kv_n = inp
        return dec[..., None] * s + kv_n, s

    s_final, s_prev = lax.scan(step, s0, (decay, kv))
    o_inter = jnp.einsum('bhncd,nbhdv->bhncv', q_dec, s_prev)
    o = (o_intra + o_inter).transpose(0, 2, 3, 1, 4).reshape(bsz, t, nh, dv)
    return o, s_final


def gla_mixer(x, s0, w_in, w_gate_up, b_gate, norm_g, w_o):
    bsz, t, _ = x.shape
    proj = x @ w_in
    q, k, v, r, gl = jnp.split(proj, [GLA_DK, 2 * GLA_DK, 2 * GLA_DK + GLA_DV, 2 * GLA_DK + 2 * GLA_DV], axis=-1)
    log_a = jax.nn.log_sigmoid((gl @ w_gate_up + b_gate).astype(jnp.float32)) / GLA_TAU
    q = q.astype(jnp.float32).reshape(bsz, t, GLA_HEADS, GLA_DK_HEAD) * (GLA_DK_HEAD ** -0.5)
    k = k.astype(jnp.float32).reshape(bsz, t, GLA_HEADS, GLA_DK_HEAD)
    v = v.astype(jnp.float32).reshape(bsz, t, GLA_HEADS, GLA_DV_HEAD)
    g = log_a.reshape(bsz, t, GLA_HEADS, GLA_DK_HEAD)
    o, s = gla_core(q, k, v, g, s0.astype(jnp.float32))
    o = o * lax.rsqrt(jnp.mean(jnp.square(o), axis=-1, keepdims=True) + RMS_EPS) * norm_g.astype(jnp.float32)
    o = o.reshape(bsz, t, GLA_DV).astype(x.dtype) * jax.nn.silu(r)
    return o @ w_o, s.astype(s0.dtype)


def conv_mixer(x, buf, w_in, w_conv, w_out):
    t = x.shape[1]
    bg, cg, h = jnp.split(x @ w_in, 3, axis=-1)
    u = cg * h
    full = jnp.concatenate([buf.astype(u.dtype), u], axis=1)
    conv = full[:, 0:t, :] * w_conv[0]
    for i in range(1, CONV_WIDTH):
        conv = conv + full[:, i:i + t, :] * w_conv[i]
    return (bg * conv) @ w_out, full[:, -(CONV_WIDTH - 1):, :].astype(buf.dtype)


def mlp(x, w_up, w_down):
    return jnp.square(jax.nn.relu(x @ w_up)) @ w_down


def trunk(x, gla_states, conv_bufs, gla_w_in, gla_w_gate_up, gla_b_gate, gla_norm_g, gla_w_o,
          conv_w_in, conv_w_conv, conv_w_out, mlp_w_up, mlp_w_down, ln1_g, ln1_b, ln2_g, ln2_b):
    new_gla, new_conv = [], []
    for i in range(DEPTH):
        j = i // N_MIXERS
        if i % N_MIXERS == 0:
            h, s = gla_mixer(x, gla_states[j], gla_w_in[j], gla_w_gate_up[j], gla_b_gate[j], gla_norm_g[j], gla_w_o[j])
            new_gla.append(s)
        else:
            h, s = conv_mixer(x, conv_bufs[j], conv_w_in[j], conv_w_conv[j], conv_w_out[j])
            new_conv.append(s)
        x = layer_norm(ALPHA * x + h, ln1_g[i], ln1_b[i])
        x = layer_norm(ALPHA * x + mlp(x, mlp_w_up[i], mlp_w_down[i]), ln2_g[i], ln2_b[i])
    return x, jnp.stack(new_gla), jnp.stack(new_conv)


def setup_inputs(seed: int = 0) -> dict:
    key = jax.random.key(seed)
    ks = jax.random.split(key, 20)
    nrm = jax.random.normal
    f32 = jnp.float32
    return {
        "x_prompt": nrm(ks[0], (BATCH, SEQ, D_MODEL), f32),
        "x_sample": nrm(ks[1], (DEC_BATCH, DEC_SEQ, D_MODEL), f32),
        "state_gla": 0.5 * nrm(ks[2], (N_GLA, DEC_BATCH, GLA_HEADS, GLA_DK_HEAD, GLA_DV_HEAD), f32),
        "state_conv": nrm(ks[3], (N_CONV, DEC_BATCH, CONV_WIDTH - 1, D_MODEL), f32),
        "gla_w_in": nrm(ks[4], (N_GLA, D_MODEL, GLA_IN), f32) * D_MODEL ** -0.5,
        "gla_w_gate_up": nrm(ks[5], (N_GLA, GLA_GATE_RANK, GLA_DK), f32) * GLA_GATE_RANK ** -0.5,
        "gla_b_gate": 0.1 * nrm(ks[6], (N_GLA, GLA_DK), f32),
        "gla_norm_g": 1.0 + 0.01 * nrm(ks[7], (N_GLA, GLA_HEADS, GLA_DV_HEAD), f32),
        "gla_w_o": nrm(ks[8], (N_GLA, GLA_DV, D_MODEL), f32) * (GLA_DV ** -0.5 * BETA),
        "conv_w_in": nrm(ks[9], (N_CONV, D_MODEL, 3 * D_MODEL), f32) * D_MODEL ** -0.5,
        "conv_w_conv": nrm(ks[10], (N_CONV, CONV_WIDTH, D_MODEL), f32) * CONV_WIDTH ** -0.5,
        "conv_w_out": nrm(ks[11], (N_CONV, D_MODEL, D_MODEL), f32) * (D_MODEL ** -0.5 * BETA),
        "mlp_w_up": nrm(ks[12], (DEPTH, D_MODEL, D_FF), f32) * D_MODEL ** -0.5,
        "mlp_w_down": nrm(ks[13], (DEPTH, D_FF, D_MODEL), f32) * (D_FF ** -0.5 * BETA),
        "ln1_g": 1.0 + 0.01 * nrm(ks[14], (DEPTH, D_MODEL), f32),
        "ln1_b": 0.01 * nrm(ks[15], (DEPTH, D_MODEL), f32),
        "ln2_g": 1.0 + 0.01 * nrm(ks[16], (DEPTH, D_MODEL), f32),
        "ln2_b": 0.01 * nrm(ks[17], (DEPTH, D_MODEL), f32),
    }


def reference(x_prompt, x_sample, state_gla, state_conv, gla_w_in, gla_w_gate_up, gla_b_gate, gla_norm_g,
              gla_w_o, conv_w_in, conv_w_conv, conv_w_out, mlp_w_up, mlp_w_down, ln1_g, ln1_b, ln2_g, ln2_b):
    weights = (gla_w_in, gla_w_gate_up, gla_b_gate, gla_norm_g, gla_w_o, conv_w_in, conv_w_conv, conv_w_out,
               mlp_w_up, mlp_w_down, ln1_g, ln1_b, ln2_g, ln2_b)
    gla0 = jnp.zeros((N_GLA, BATCH, GLA_HEADS, GLA_DK_HEAD, GLA_DV_HEAD), state_gla.dtype)
    conv0 = jnp.zeros((N_CONV, BATCH, CONV_WIDTH - 1, D_MODEL), state_conv.dtype)
    y_prompt, gla_p, conv_p = trunk(x_prompt, gla0, conv0, *weights)
    y_sample, gla_s, conv_s = trunk(x_sample, state_gla, state_conv, *weights)
    return (y_prompt, y_sample, gla_p, gla_s, conv_p, conv_s)
```

```cpp
#include <hip/hip_runtime.h>
#include <hip/hip_cooperative_groups.h>
#include <cstdio>
#include <cstdint>
namespace cg = cooperative_groups;
namespace pg8 {
#define PG8_LAS __attribute__((address_space(3)))
typedef unsigned short bf16_t;
typedef short bf16x8 __attribute__((ext_vector_type(8)));
typedef float f32x4 __attribute__((ext_vector_type(4)));
typedef unsigned u32x4 __attribute__((ext_vector_type(4)));
constexpr int BM = 256, BK = 64, HALF = 128, HTB = HALF * BK * 2  , STAGE_BYTES = 8 * HTB, NXCD = 8, WGM = 8;

__host__ __device__ __forceinline__ int lds_byte(int r, int c) { const int st = (r >> 4) * 2 + (c >> 5), rr = r & 15, cc = c & 31, ob = rr * 64 + cc * 2; return st * 1024 + (ob ^ (((ob >> 9) & 1) << 5)); }
__host__ __device__ __forceinline__ void stage_rc(int b, int& R, int& C) { const int st = b / 1024, sb = b % 1024, swz = sb ^ (((sb >> 9) & 1) << 5); R = (st >> 1) * 16 + swz / 64; C = (st & 1) * 32 + (swz % 64) / 2; }
__host__ __device__ __forceinline__ int perm32(int rho) { const int n = rho >> 4, i = rho & 15; return 8 * (i >> 2) + 4 * n + (i & 3); }

struct Unit { int pm, pn; };
struct Gemm { const bf16_t* A; const bf16_t* Bt; int M, N, K; };

struct StaticOrder {
    int nM, nN, nwg, G, c;
    __host__ __device__ void init(int M, int N, int G_, int c_) { nM = M / BM; nN = N / BM; nwg = nM * nN; G = G_; c = c_; }
    __host__ __device__ bool next(int i, Unit& u) const {
        const long L = (long)i * G + c; if (L >= nwg) return false;
        int wgid = (int)L; { const int q = nwg / NXCD, r = nwg % NXCD, xcd = wgid % NXCD, off = wgid / NXCD; wgid = (xcd < r ? xcd * (q + 1) : r * (q + 1) + (xcd - r) * q) + off; }
        const int nig = WGM * nN, gid = wgid / nig, fm = gid * WGM, gsz = (nM - fm) < WGM ? (nM - fm) : WGM;
        u.pm = fm + ((wgid % nig) % gsz); u.pn = (wgid % nig) / gsz; return true;
    }
    __device__ __forceinline__ void a_ready(const Unit&) const {}
    __device__ __forceinline__ void done(const Unit&) const {}
};

__device__ __forceinline__ unsigned cvt_pk_bf16(float lo, float hi) { unsigned r; asm volatile("v_cvt_pk_bf16_f32 %0, %1, %2" : "=v"(r) : "v"(lo), "v"(hi)); return r; }
typedef float f32x2 __attribute__((ext_vector_type(2)));
constexpr int NPROMPT = 16384;
__device__ __forceinline__ float bf2f(unsigned h) { return __uint_as_float(h << 16); }
template <int ACT  > struct EpiStore {
    static constexpr bool PERM = true, AFTER_DRAIN = false;
    bf16_t* O; int ldc;
    __device__ __forceinline__ void operator()(const f32x4 (&acc)[2][2][4][2], const Unit& u, int wr, int wc, int fr, int fq) const {
        const int row0 = u.pm * BM + wr * 64 + fr, col0 = u.pn * BM + wc * 32 + 8 * fq;
#pragma unroll
        for (int ai = 0; ai < 2; ++ai)
#pragma unroll
            for (int m = 0; m < 4; ++m) { bf16_t* rowp = O + (size_t)(row0 + ai * HALF + m * 16) * ldc + col0;
#pragma unroll
                for (int bj = 0; bj < 2; ++bj) { f32x4 v0 = acc[ai][bj][m][0], v1 = acc[ai][bj][m][1];
                    if (ACT == 1) {
#pragma unroll
                        for (int e = 0; e < 4; ++e) { float a = fmaxf(v0[e], 0.f), b = fmaxf(v1[e], 0.f); v0[e] = a * a; v1[e] = b * b; } }
                    u32x4 w; w.x = cvt_pk_bf16(v0[0], v0[1]); w.y = cvt_pk_bf16(v0[2], v0[3]); w.z = cvt_pk_bf16(v1[0], v1[1]); w.w = cvt_pk_bf16(v1[2], v1[3]);
                    *(u32x4*)(rowp + bj * HALF) = w; } }
    }
};
struct EpiResid {
    static constexpr bool PERM = true, AFTER_DRAIN = false;
    float* Z; const float* xp; const float* xs; const bf16_t* xb; float alpha;
    __device__ __forceinline__ void operator()(const f32x4 (&acc)[2][2][4][2], const Unit& u, int wr, int wc, int fr, int fq) const {
        const int row0 = u.pm * BM + wr * 64 + fr, col0 = u.pn * BM + wc * 32 + 8 * fq;
#pragma unroll
        for (int ai = 0; ai < 2; ++ai)
#pragma unroll
            for (int m = 0; m < 4; ++m) { const int row = row0 + ai * HALF + m * 16;
#pragma unroll
                for (int bj = 0; bj < 2; ++bj) { const int col = col0 + bj * HALF; f32x4 r0, r1;
                    if (xb) { const u32x4 w = *(const u32x4*)(xb + (size_t)row * 1024 + col);
                        r0 = (f32x4){bf2f(w.x & 0xffffu), bf2f(w.x >> 16), bf2f(w.y & 0xffffu), bf2f(w.y >> 16)};
                        r1 = (f32x4){bf2f(w.z & 0xffffu), bf2f(w.z >> 16), bf2f(w.w & 0xffffu), bf2f(w.w >> 16)}; }
                    else { const float* xr = (row < NPROMPT) ? xp + (size_t)row * 1024 : xs + (size_t)(row - NPROMPT) * 1024;
                        r0 = *(const f32x4*)(xr + col); r1 = *(const f32x4*)(xr + col + 4); }
                    float* zp = Z + (size_t)row * 1024 + col;
                    *(f32x4*)zp = r0 * alpha + acc[ai][bj][m][0]; *(f32x4*)(zp + 4) = r1 * alpha + acc[ai][bj][m][1]; } }
    }
};
struct EpiGlaIn {
    static constexpr bool PERM = true, AFTER_DRAIN = false;
    bf16_t *QD, *KD, *KS, *V, *RS; const float* Bc;
    __device__ __forceinline__ void operator()(const f32x4 (&acc)[2][2][4][2], const Unit& u, int wr, int wc, int fr, int fq) const {
        const int row0 = u.pm * BM + wr * 64 + fr, cw = wc * 32 + 8 * fq, pn = u.pn;
#pragma unroll
        for (int ai = 0; ai < 2; ++ai)
#pragma unroll
            for (int m = 0; m < 4; ++m) { const int row = row0 + ai * HALF + m * 16; const int lrow = (row < NPROMPT) ? (row | 63) : (row | 3);
#pragma unroll
                for (int bj = 0; bj < 2; ++bj) { f32x4 v0 = acc[ai][bj][m][0], v1 = acc[ai][bj][m][1]; u32x4 w;
                    if (pn < 4) {
                        const int cl = (pn & 1) * 256 + bj * HALF + cw;
                        const f32x4 b0 = *(const f32x4*)(Bc + (size_t)row * 512 + cl), b1 = *(const f32x4*)(Bc + (size_t)row * 512 + cl + 4);
                        if (pn < 2) {
#pragma unroll
                            for (int e = 0; e < 4; ++e) { v0[e] = v0[e] * 0.08838834764831845f * __expf(b0[e]); v1[e] = v1[e] * 0.08838834764831845f * __expf(b1[e]); }
                            w.x = cvt_pk_bf16(v0[0], v0[1]); w.y = cvt_pk_bf16(v0[2], v0[3]); w.z = cvt_pk_bf16(v1[0], v1[1]); w.w = cvt_pk_bf16(v1[2], v1[3]);
                            *(u32x4*)(QD + (size_t)row * 512 + cl) = w;
                        } else {
                            const f32x4 l0 = *(const f32x4*)(Bc + (size_t)lrow * 512 + cl), l1 = *(const f32x4*)(Bc + (size_t)lrow * 512 + cl + 4);
                            f32x4 s0, s1;
#pragma unroll
                            for (int e = 0; e < 4; ++e) { s0[e] = v0[e] * __expf(l0[e] - b0[e]); s1[e] = v1[e] * __expf(l1[e] - b1[e]); v0[e] = v0[e] * __expf(-b0[e]); v1[e] = v1[e] * __expf(-b1[e]); }
                            w.x = cvt_pk_bf16(v0[0], v0[1]); w.y = cvt_pk_bf16(v0[2], v0[3]); w.z = cvt_pk_bf16(v1[0], v1[1]); w.w = cvt_pk_bf16(v1[2], v1[3]);
                            *(u32x4*)(KD + (size_t)row * 512 + cl) = w;
                            w.x = cvt_pk_bf16(s0[0], s0[1]); w.y = cvt_pk_bf16(s0[2], s0[3]); w.z = cvt_pk_bf16(s1[0], s1[1]); w.w = cvt_pk_bf16(s1[2], s1[3]);
                            *(u32x4*)(KS + (size_t)row * 512 + cl) = w;
                        }
                    } else {
                        const int cl = ((pn - 4) & 3) * 256 + bj * HALF + cw;
                        if (pn >= 8) {
#pragma unroll
                            for (int e = 0; e < 4; ++e) { v0[e] = v0[e] / (1.f + __expf(-v0[e])); v1[e] = v1[e] / (1.f + __expf(-v1[e])); } }
                        w.x = cvt_pk_bf16(v0[0], v0[1]); w.y = cvt_pk_bf16(v0[2], v0[3]); w.z = cvt_pk_bf16(v1[0], v1[1]); w.w = cvt_pk_bf16(v1[2], v1[3]);
                        if (pn >= 8) *(u32x4*)(RS + (size_t)row * 1024 + cl) = w; else *(u32x4*)(V + (size_t)row * 1024 + cl) = w;
                    } } }
    }
};
template <class Epi, class Sched, bool ALIGN_EPI = false, bool SP2 = false>
__device__ __forceinline__ void gemm_phase(PG8_LAS unsigned char* lds, const Gemm g, const Sched& S, const Epi& E) {
    const int tid = threadIdx.x, wid = __builtin_amdgcn_readfirstlane(tid >> 6), lane = tid & 63, wr = wid >> 2, wc = wid & 3, fr = lane & 15, fq = lane >> 4;
    const int K = g.K, nt = K / BK;
    unsigned voffA[2], voffB[2];
#pragma unroll
    for (int i = 0; i < 2; ++i) { int R, C; stage_rc(tid * 16 + i * 8192, R, C); const int Rb = Epi::PERM ? ((R & ~31) + perm32(R & 31)) : R;
        voffA[i] = (unsigned)(R * K + C) * 2u; voffB[i] = (unsigned)(Rb * K + C) * 2u; }
    const size_t kstep = (size_t)(BK * 2);
    const size_t hstep = (size_t)HALF * K * 2;
    const size_t tstep = 2 * hstep;
    const unsigned ldsw = (unsigned)wid * 1024u;
    const int aoff = lds_byte(wr * 64 + fr, fq * 8), boff = lds_byte(wc * 32 + fr, fq * 8);
#define PG8_SA(b, h) (((b) * 2 + (h)) * HTB)
#define PG8_SB(b, h) ((4 + (b) * 2 + (h)) * HTB)
#define PG8_STAGE(bufoff, gbase, voff) do { _Pragma("unroll") for (int _i = 0; _i < 2; ++_i) \
        __builtin_amdgcn_global_load_lds((const unsigned*)((const char*)(gbase) + (voff)[_i]), (PG8_LAS unsigned*)(lds + (bufoff) + ldsw + _i * 8192), 16, 0, 0); } while (0)
#define PG8_LDA(dst, b, h) do { _Pragma("unroll") for (int m = 0; m < 4; ++m) _Pragma("unroll") for (int k = 0; k < 2; ++k) dst[m][k] = *(const PG8_LAS bf16x8*)(lds + PG8_SA(b, h) + aoff + m * 2048 + k * 1024); } while (0)
#define PG8_LDB(dst, b, h) do { _Pragma("unroll") for (int n = 0; n < 2; ++n) _Pragma("unroll") for (int k = 0; k < 2; ++k) dst[n][k] = *(const PG8_LAS bf16x8*)(lds + PG8_SB(b, h) + boff + n * 2048 + k * 1024); } while (0)
#define PG8_MMA(ai, bj, At, Bt) do { __builtin_amdgcn_s_setprio(1); _Pragma("unroll") for (int m = 0; m < 4; ++m) _Pragma("unroll") for (int n = 0; n < 2; ++n) _Pragma("unroll") for (int k = 0; k < 2; ++k) \
        acc[ai][bj][m][n] = __builtin_amdgcn_mfma_f32_16x16x32_bf16(Bt[n][k], At[m][k], acc[ai][bj][m][n], 0, 0, 0); __builtin_amdgcn_s_setprio(0); } while (0)
#define PG8_WAIT_V(n) asm volatile("s_waitcnt vmcnt(" #n ")" ::: "memory")
#define PG8_WAIT_L(n) asm volatile("s_waitcnt lgkmcnt(" #n ")" ::: "memory")
#define PG8_BAR __builtin_amdgcn_s_barrier()
#define PG8_SCHED __builtin_amdgcn_sched_barrier(0)
    Unit cur, nxt; int ui = 0;
    if (!S.next(0, cur)) return;
    f32x4 acc[2][2][4][2];
#pragma unroll
    for (int a = 0; a < 2; ++a)
#pragma unroll
        for (int b = 0; b < 2; ++b)
#pragma unroll
            for (int m = 0; m < 4; ++m)
#pragma unroll
                for (int n = 0; n < 2; ++n) acc[a][b][m][n] = (f32x4){0.f, 0.f, 0.f, 0.f};
    bf16x8 At[4][2], B0[2][2], B1[2][2];
    const char* cA = (const char*)g.A + (size_t)cur.pm * tstep; const char* cB = (const char*)g.Bt + (size_t)cur.pn * tstep;
    S.a_ready(cur);
    if constexpr (SP2) {
        PG8_STAGE(PG8_SB(0, 0), cB, voffB); PG8_STAGE(PG8_SB(0, 1), cB + hstep, voffB); PG8_STAGE(PG8_SA(0, 0), cA, voffA); PG8_STAGE(PG8_SA(0, 1), cA + hstep, voffA);
        if (wr == 1) PG8_BAR;
        PG8_WAIT_V(2); PG8_BAR;
        PG8_STAGE(PG8_SB(1, 0), cB + kstep, voffB); PG8_STAGE(PG8_SA(1, 0), cA + kstep, voffA); PG8_STAGE(PG8_SB(1, 1), cB + hstep + kstep, voffB);
        PG8_WAIT_V(6); PG8_BAR;
    } else {
        PG8_STAGE(PG8_SB(0, 0), cB, voffB); PG8_STAGE(PG8_SA(0, 0), cA, voffA); PG8_STAGE(PG8_SB(0, 1), cB + hstep, voffB); PG8_STAGE(PG8_SA(0, 1), cA + hstep, voffA);
        if (wr == 1) PG8_BAR;
        PG8_WAIT_V(4); PG8_BAR;
        PG8_STAGE(PG8_SB(1, 0), cB + kstep, voffB); PG8_STAGE(PG8_SA(1, 0), cA + kstep, voffA); PG8_STAGE(PG8_SB(1, 1), cB + hstep + kstep, voffB);
        PG8_WAIT_V(6); PG8_BAR;
    }
    for (;;) {
        const bool has_next = S.next(ui + 1, nxt);
        const char* nA = has_next ? (const char*)g.A + (size_t)nxt.pm * tstep : cA; const char* nB = has_next ? (const char*)g.Bt + (size_t)nxt.pn * tstep : cB;
        for (int t = 0; t < nt; t += 2) {
            const bool last = (t == nt - 2);
            const char* a1 = cA + (size_t)(t + 1) * kstep;
            const char* a2 = last ? nA : cA + (size_t)(t + 2) * kstep; const char* b2 = last ? nB : cB + (size_t)(t + 2) * kstep;
            const char* a3 = a2 + kstep; const char* b3 = b2 + kstep;
            if (last && has_next) S.a_ready(nxt);
            if constexpr (SP2) {
            PG8_LDB(B0, 0, 0); PG8_LDB(B1, 0, 1); PG8_SCHED; PG8_LDA(At, 0, 0); PG8_STAGE(PG8_SA(1, 1), a1 + hstep, voffA);
            PG8_WAIT_V(8); PG8_WAIT_L(0); PG8_BAR; PG8_MMA(0, 0, At, B0); PG8_MMA(0, 1, At, B1); PG8_BAR; PG8_SCHED;
            PG8_LDA(At, 0, 1); PG8_STAGE(PG8_SB(0, 0), b2, voffB); PG8_STAGE(PG8_SB(0, 1), b2 + hstep, voffB); PG8_STAGE(PG8_SA(0, 0), a2, voffA);
            PG8_WAIT_V(8); PG8_WAIT_L(0); PG8_BAR; PG8_MMA(1, 0, At, B0); PG8_MMA(1, 1, At, B1); PG8_BAR; PG8_SCHED;
            PG8_LDB(B0, 1, 0); PG8_LDB(B1, 1, 1); PG8_SCHED; PG8_LDA(At, 1, 0); PG8_STAGE(PG8_SA(0, 1), a2 + hstep, voffA);
            PG8_WAIT_V(8); PG8_WAIT_L(0); PG8_BAR; PG8_MMA(0, 0, At, B0); PG8_MMA(0, 1, At, B1); PG8_BAR; PG8_SCHED;
            PG8_LDA(At, 1, 1); PG8_STAGE(PG8_SB(1, 0), b3, voffB); PG8_STAGE(PG8_SB(1, 1), b3 + hstep, voffB); PG8_STAGE(PG8_SA(1, 0), a3, voffA);
            PG8_WAIT_V(8); PG8_WAIT_L(0); PG8_BAR; PG8_MMA(1, 0, At, B0); PG8_MMA(1, 1, At, B1); PG8_BAR; PG8_SCHED;
            } else {
            PG8_LDB(B0, 0, 0); PG8_SCHED; PG8_LDA(At, 0, 0); PG8_STAGE(PG8_SA(1, 1), a1 + hstep, voffA);
            PG8_WAIT_L(8); PG8_BAR; PG8_WAIT_L(0); PG8_MMA(0, 0, At, B0); PG8_BAR; PG8_SCHED;
            PG8_LDB(B1, 0, 1); PG8_STAGE(PG8_SB(0, 0), b2, voffB);
            PG8_BAR; PG8_WAIT_L(0); PG8_MMA(0, 1, At, B1); PG8_BAR;
            PG8_LDA(At, 0, 1); PG8_STAGE(PG8_SA(0, 0), a2, voffA);
            PG8_BAR; PG8_WAIT_L(0); PG8_MMA(1, 0, At, B0); PG8_BAR; PG8_SCHED;
            PG8_STAGE(PG8_SB(0, 1), b2 + hstep, voffB);
            PG8_WAIT_V(6); PG8_BAR; PG8_MMA(1, 1, At, B1); PG8_BAR;
            PG8_LDB(B0, 1, 0); PG8_SCHED; PG8_LDA(At, 1, 0); PG8_STAGE(PG8_SA(0, 1), a2 + hstep, voffA);
            PG8_WAIT_L(8); PG8_BAR; PG8_WAIT_L(0); PG8_MMA(0, 0, At, B0); PG8_BAR; PG8_SCHED;
            PG8_LDB(B1, 1, 1); PG8_STAGE(PG8_SB(1, 0), b3, voffB);
            PG8_BAR; PG8_WAIT_L(0); PG8_MMA(0, 1, At, B1); PG8_BAR;
            PG8_LDA(At, 1, 1); PG8_STAGE(PG8_SA(1, 0), a3, voffA);
            PG8_BAR; PG8_WAIT_L(0); PG8_MMA(1, 0, At, B0); PG8_BAR; PG8_SCHED;
            PG8_STAGE(PG8_SB(1, 1), b3 + hstep, voffB);
            PG8_WAIT_V(6); PG8_BAR; PG8_MMA(1, 1, At, B1); PG8_BAR;
            }
        }
        if constexpr (ALIGN_EPI) { if (wr == 0) PG8_BAR; }
        if constexpr (!Epi::AFTER_DRAIN) { E(acc, cur, wr, wc, fr, fq); S.done(cur); }
        if (!has_next) break;
#pragma unroll
        for (int a = 0; a < 2; ++a)
#pragma unroll
            for (int b = 0; b < 2; ++b)
#pragma unroll
                for (int m = 0; m < 4; ++m)
#pragma unroll
                    for (int n = 0; n < 2; ++n) acc[a][b][m][n] = (f32x4){0.f, 0.f, 0.f, 0.f};
        cur = nxt; cA = nA; cB = nB; ++ui;
        if constexpr (ALIGN_EPI) { if (wr == 1) PG8_BAR; }
    }
    PG8_WAIT_V(0);
    if constexpr (!ALIGN_EPI) { if (wr == 0) PG8_BAR; }
    PG8_BAR;
    if constexpr (Epi::AFTER_DRAIN) { E.fused(acc, cur, wr, wc, fr, fq, lds, wid, lane); S.done(cur); }
#undef PG8_SA
#undef PG8_SB
#undef PG8_STAGE
#undef PG8_LDA
#undef PG8_LDB
#undef PG8_MMA
#undef PG8_WAIT_V
#undef PG8_WAIT_L
#undef PG8_BAR
#undef PG8_SCHED
}
}
#define LAS __attribute__((address_space(3)))
typedef unsigned short bf16;
typedef float f32x4 __attribute__((ext_vector_type(4)));
typedef short bf16x8 __attribute__((ext_vector_type(8)));
typedef unsigned v4u __attribute__((ext_vector_type(4)));
typedef unsigned v2u __attribute__((ext_vector_type(2)));

constexpr int NWAVES = 8, NT = NWAVES * 64;
constexpr int D = 1024, NP = 16384, NS = 512, M = NP + NS, FF = 4096, SEQ = 2048;
constexpr int GIN = 3088;
constexpr float ALPHA = 1.4142135623730951f, LN_EPS = 1e-5f, RMS_EPS = 1e-6f;
constexpr int LDS_BYTES = 147456;
constexpr size_t O_Y = 0, O_GLAP = 17301504, O_GLAS = 18350080, O_CONVP = 35127296, O_CONVS = 35143680;
constexpr size_t MiB = 1u << 20;
constexpr size_t WS_WGIN = 1 * MiB, WS_WCIN = 7 * MiB, WS_WO = 13 * MiB, WS_WOUT = 15 * MiB, WS_WUP0 = 17 * MiB, WS_WUP1 = 25 * MiB, WS_WDN0 = 33 * MiB, WS_WDN1 = 41 * MiB;
constexpr size_t WS_R0 = 49 * MiB;
constexpr size_t WS_R1 = 82 * MiB;
constexpr size_t WS_QD = 115 * MiB, WS_KD = WS_QD + (size_t)M * 512 * 2, WS_KS = WS_KD + (size_t)M * 512 * 2, WS_V = WS_KS + (size_t)M * 512 * 2, WS_RS = WS_V + (size_t)M * 1024 * 2;
constexpr size_t WS_H = 115 * MiB;
static_assert(WS_RS + (size_t)M * 1024 * 2 <= 256 * MiB && WS_H + (size_t)M * FF * 2 <= 256 * MiB, "ws map");

__device__ __forceinline__ float bf2f(unsigned h) { return __uint_as_float(h << 16); }
__device__ __forceinline__ unsigned f2bf(float f) { unsigned u = __builtin_bit_cast(unsigned, f); return (u + 0x7fffu + ((u >> 16) & 1u)) >> 16; }
__device__ __forceinline__ unsigned pk2(float lo, float hi) { return f2bf(lo) | (f2bf(hi) << 16); }
__device__ __forceinline__ float wave_sum(float v) {
#pragma unroll
    for (int o = 1; o < 64; o <<= 1) v += __shfl_xor(v, o);
    return v;
}
#define LDS_WAIT() asm volatile("s_waitcnt lgkmcnt(0)" ::: "memory")

__device__ __forceinline__ void transpose_item(const float* W, int K, int N, int ld, bf16* WT, LAS float* scr, int item, int lane) {
    const int nblk = N / 32, kb = item / nblk, nb = item % nblk, k0 = 64 * kb, n0 = 32 * nb;
#pragma unroll 8
    for (int i = 0; i < 32; ++i) { const int kk = 2 * i + (lane >> 5); scr[kk * 33 + (lane & 31)] = W[(size_t)(k0 + kk) * ld + n0 + (lane & 31)]; }
    LDS_WAIT(); asm volatile("" ::: "memory");
    const int c = lane & 7;
#pragma unroll
    for (int j = 0; j < 4; ++j) { const int n = (lane >> 3) + 8 * j; const LAS float* s = scr + (8 * c) * 33 + n;
        v4u o; o.x = pk2(s[0 * 33], s[1 * 33]); o.y = pk2(s[2 * 33], s[3 * 33]); o.z = pk2(s[4 * 33], s[5 * 33]); o.w = pk2(s[6 * 33], s[7 * 33]);
        *(v4u*)(WT + (size_t)(n0 + n) * K + k0 + 8 * c) = o; }
    LDS_WAIT(); asm volatile("" ::: "memory");
}

template <bool OUT_F32>
__device__ __forceinline__ void ln_row(const float* zrow, const float* g, const float* bta, void* orow, int lane) {
    const f32x4* xr = (const f32x4*)zrow + lane;
    f32x4 v[4]; float s = 0.f;
#pragma unroll
    for (int j = 0; j < 4; ++j) { v[j] = xr[64 * j]; s += (v[j].x + v[j].y) + (v[j].z + v[j].w); }
    const float mean = wave_sum(s) * (1.f / D); float s2 = 0.f;
#pragma unroll
    for (int j = 0; j < 4; ++j) { v[j] = v[j] - mean; s2 += (v[j].x * v[j].x + v[j].y * v[j].y) + (v[j].z * v[j].z + v[j].w * v[j].w); }
    const float rstd = 1.f / sqrtf(wave_sum(s2) * (1.f / D) + LN_EPS);
#pragma unroll
    for (int j = 0; j < 4; ++j) { const f32x4 gg = ((const f32x4*)g)[lane + 64 * j], bb = ((const f32x4*)bta)[lane + 64 * j]; const f32x4 o = v[j] * rstd * gg + bb;
        if (OUT_F32) ((f32x4*)orow)[lane + 64 * j] = o;
        else { v2u w; w.x = pk2(o.x, o.y); w.y = pk2(o.z, o.w); ((v2u*)orow)[lane + 64 * j] = w; } }
}
__device__ __forceinline__ float logsig(float x) { return fminf(x, 0.f) - log1pf(expf(-fabsf(x))); }

__device__ __forceinline__ void gate_item(LAS unsigned char* lds, int item, const float* xp, const float* xs, const float* w_in, const float* w_up, const float* b_gate, float* Bc, int tid) {
    LAS float* Wgl = (LAS float*)lds;
    LAS float* gl = (LAS float*)(lds + 65536);
    const int R0 = item * 64; const bool samp = R0 >= NP;
    const float* xbase = samp ? xs + (size_t)(R0 - NP) * D : xp + (size_t)R0 * D;
    for (int e = tid; e < 1024 * 16; e += NT) Wgl[e] = w_in[(size_t)(e >> 4) * GIN + 3072 + (e & 15)];
    __syncthreads();
    {
        const int r = tid >> 3, t8 = tid & 7;
        f32x4 a0 = {0.f, 0.f, 0.f, 0.f}, a1 = a0, a2 = a0, a3 = a0;
        const float* xr = xbase + (size_t)r * D;
#pragma unroll 4
        for (int it = 0; it < 32; ++it) { const int k4 = (it * 8 + t8) * 4; const f32x4 xv = *(const f32x4*)(xr + k4);
#pragma unroll
            for (int kk = 0; kk < 4; ++kk) { const LAS f32x4* wr_ = (const LAS f32x4*)(Wgl + (k4 + kk) * 16); const float xe = xv[kk];
                a0 += wr_[0] * xe; a1 += wr_[1] * xe; a2 += wr_[2] * xe; a3 += wr_[3] * xe; } }
#pragma unroll
        for (int o = 1; o < 8; o <<= 1) {
#pragma unroll
            for (int e = 0; e < 4; ++e) { a0[e] += __shfl_xor(a0[e], o); a1[e] += __shfl_xor(a1[e], o); a2[e] += __shfl_xor(a2[e], o); a3[e] += __shfl_xor(a3[e], o); } }
        if (t8 == 0) { LAS f32x4* gp = (LAS f32x4*)(gl + r * 16); gp[0] = a0; gp[1] = a1; gp[2] = a2; gp[3] = a3; }
    }
    __syncthreads();
    {
        const int c = tid; float wu[16];
#pragma unroll
        for (int j = 0; j < 16; ++j) wu[j] = w_up[j * 512 + c];
        const float bg = b_gate[c]; float run = 0.f;
        for (int r = 0; r < 64; ++r) { const LAS f32x4* gp = (const LAS f32x4*)(gl + r * 16); float pre = bg;
#pragma unroll
            for (int q = 0; q < 4; ++q) { const f32x4 gv = gp[q]; pre += gv.x * wu[4 * q] + gv.y * wu[4 * q + 1] + gv.z * wu[4 * q + 2] + gv.w * wu[4 * q + 3]; }
            const float g = logsig(pre) * 0.0625f;
            if (samp && (r & 3) == 0) run = 0.f;
            run += g; Bc[(size_t)(R0 + r) * 512 + c] = run; }
    }
    __syncthreads();
}

#define MFMA16(a, b, c) __builtin_amdgcn_mfma_f32_16x16x32_bf16((a), (b), (c), 0, 0, 0)
__device__ __forceinline__ void gla_prompt_item(LAS unsigned char* lds, int item, const bf16* QD, const bf16* KD, const bf16* KS, const bf16* V, const float* Bc, bf16* OB, float* gla_p, int tid) {
    const int wid = __builtin_amdgcn_readfirstlane(tid >> 6), lane = tid & 63, l16 = lane & 15, quad = lane >> 4;
    const int s = item & 7, h = (item >> 3) & 3, b = item >> 5;
    LAS bf16* Vt = (LAS bf16*)lds;
    LAS bf16* KSt = (LAS bf16*)(lds + 4608);
    LAS bf16* Pb = (LAS bf16*)(lds + 23040);
    LAS bf16* St = (LAS bf16*)(lds + 32256);
    f32x4 S0 = {0.f, 0.f, 0.f, 0.f}, S1 = S0;
    const int ib = wid >> 1, jb0 = (wid & 1) * 2, vb = wid & 1;
    for (int n = 0; n < 32; ++n) {
        const size_t r0 = (size_t)b * SEQ + n * 64;
        { const int j = tid >> 3, c4 = (tid & 7) * 4;
          const v2u vv = *(const v2u*)(V + (r0 + j) * 1024 + h * 256 + s * 32 + c4);
          Vt[(c4 + 0) * 72 + j] = (bf16)(vv.x & 0xffffu); Vt[(c4 + 1) * 72 + j] = (bf16)(vv.x >> 16); Vt[(c4 + 2) * 72 + j] = (bf16)(vv.y & 0xffffu); Vt[(c4 + 3) * 72 + j] = (bf16)(vv.y >> 16);
          const int c16 = (tid & 7) * 16;
          const v4u k0 = *(const v4u*)(KS + (r0 + j) * 512 + h * 128 + c16), k1 = *(const v4u*)(KS + (r0 + j) * 512 + h * 128 + c16 + 8);
#pragma unroll
          for (int e = 0; e < 4; ++e) { KSt[(c16 + 2 * e) * 72 + j] = (bf16)(k0[e] & 0xffffu); KSt[(c16 + 2 * e + 1) * 72 + j] = (bf16)(k0[e] >> 16);
                                        KSt[(c16 + 8 + 2 * e) * 72 + j] = (bf16)(k1[e] & 0xffffu); KSt[(c16 + 8 + 2 * e + 1) * 72 + j] = (bf16)(k1[e] >> 16); }
          v2u w; w.x = pk2(S0[0], S0[1]); w.y = pk2(S0[2], S0[3]); *(LAS v2u*)(St + l16 * 136 + 16 * wid + quad * 4) = w;
          w.x = pk2(S1[0], S1[1]); w.y = pk2(S1[2], S1[3]); *(LAS v2u*)(St + (16 + l16) * 136 + 16 * wid + quad * 4) = w; }
        bf16x8 qa[4];
        { const bf16* qp = QD + (r0 + ib * 16 + l16) * 512 + h * 128 + quad * 8;
#pragma unroll
          for (int kk = 0; kk < 4; ++kk) qa[kk] = *(const bf16x8*)(qp + kk * 32);
#pragma unroll
          for (int jj = 0; jj < 2; ++jj) { const int jb = jb0 + jj; f32x4 p = {0.f, 0.f, 0.f, 0.f};
              const bf16* kp = KD + (r0 + jb * 16 + l16) * 512 + h * 128 + quad * 8;
#pragma unroll
              for (int kk = 0; kk < 4; ++kk) { const bf16x8 kb = *(const bf16x8*)(kp + kk * 32); p = MFMA16(qa[kk], kb, p); }
#pragma unroll
              for (int t = 0; t < 4; ++t) { const int i = ib * 16 + quad * 4 + t, jcol = jb * 16 + l16; Pb[i * 72 + jcol] = (bf16)f2bf(jcol <= i ? p[t] : 0.f); } } }
        __syncthreads();
        { f32x4 o = {0.f, 0.f, 0.f, 0.f};
#pragma unroll
          for (int kk = 0; kk < 2; ++kk) { const bf16x8 va = *(const LAS bf16x8*)(Vt + (vb * 16 + l16) * 72 + kk * 32 + quad * 8), pbv = *(const LAS bf16x8*)(Pb + (ib * 16 + l16) * 72 + kk * 32 + quad * 8); o = MFMA16(va, pbv, o); }
#pragma unroll
          for (int kk = 0; kk < 4; ++kk) { const bf16x8 sa = *(const LAS bf16x8*)(St + (vb * 16 + l16) * 136 + kk * 32 + quad * 8); o = MFMA16(sa, qa[kk], o); }
          v2u w; w.x = pk2(o[0], o[1]); w.y = pk2(o[2], o[3]);
          *(v2u*)(OB + (r0 + ib * 16 + l16) * 1024 + h * 256 + s * 32 + vb * 16 + quad * 4) = w; }
        { const f32x4 bl = *(const f32x4*)(Bc + (r0 + 63) * 512 + h * 128 + 16 * wid + quad * 4);
#pragma unroll
          for (int t = 0; t < 4; ++t) { const float dc = __expf(bl[t]); S0[t] *= dc; S1[t] *= dc; }
#pragma unroll
          for (int kk = 0; kk < 2; ++kk) { const bf16x8 ka = *(const LAS bf16x8*)(KSt + (16 * wid + l16) * 72 + kk * 32 + quad * 8);
              const bf16x8 v0 = *(const LAS bf16x8*)(Vt + l16 * 72 + kk * 32 + quad * 8), v1 = *(const LAS bf16x8*)(Vt + (16 + l16) * 72 + kk * 32 + quad * 8);
              S0 = MFMA16(ka, v0, S0); S1 = MFMA16(ka, v1, S1); } }
        __syncthreads();
    }
    float* sp = gla_p + ((size_t)(b * 4 + h) * 128 + 16 * wid + quad * 4) * 256 + s * 32 + l16;
#pragma unroll
    for (int t = 0; t < 4; ++t) { sp[(size_t)t * 256] = S0[t]; sp[(size_t)t * 256 + 16] = S1[t]; }
}

__device__ __forceinline__ void gla_sample_item(LAS unsigned char* lds, int item, const bf16* QD, const bf16* KD, const bf16* KS, const bf16* V, const float* Bc, const float* st_in, bf16* OB, float* gla_s, int tid) {
    LAS float* qf = (LAS float*)lds;
    LAS float* kdf = qf + 512;
    LAS float* ksf = kdf + 512;
    LAS float* decf = ksf + 512;
    LAS float* Pm = decf + 128;
    LAS float* vf = Pm + 16;
    LAS float* part = vf + 1024;
    const int b = item >> 2, h = item & 3; const size_t r0 = (size_t)NP + b * 4;
    { const int i = tid >> 7, d = tid & 127; const size_t o = (r0 + i) * 512 + h * 128 + d;
      qf[tid] = bf2f(QD[o]); kdf[tid] = bf2f(KD[o]); ksf[tid] = bf2f(KS[o]);
      if (tid < 128) decf[tid] = __expf(Bc[(r0 + 3) * 512 + h * 128 + tid]);
#pragma unroll
      for (int q = 0; q < 2; ++q) { const int e = tid + q * 512, j = e >> 8, v = e & 255; vf[e] = bf2f(V[(r0 + j) * 1024 + h * 256 + v]); } }
    __syncthreads();
    if (tid < 16) { const int i = tid >> 2, j = tid & 3; float p = 0.f;
        if (j <= i) for (int d = 0; d < 128; ++d) p += qf[i * 128 + d] * kdf[j * 128 + d];
        Pm[tid] = p; }
    {
        const int v4 = (tid & 63) * 4, g = tid >> 6;
        f32x4 vv[4], pt[4];
#pragma unroll
        for (int j = 0; j < 4; ++j) { vv[j] = *(const LAS f32x4*)(vf + j * 256 + v4); pt[j] = (f32x4){0.f, 0.f, 0.f, 0.f}; }
        const size_t sbase = ((size_t)(b * 4 + h) * 128 + g * 16) * 256 + v4;
#pragma unroll 4
        for (int dd = 0; dd < 16; ++dd) { const int d = g * 16 + dd; const f32x4 s0 = *(const f32x4*)(st_in + sbase + (size_t)dd * 256);
            f32x4 sn = s0 * decf[d];
#pragma unroll
            for (int j = 0; j < 4; ++j) { pt[j] += s0 * qf[j * 128 + d]; sn += vv[j] * ksf[j * 128 + d]; }
            *(f32x4*)(gla_s + sbase + (size_t)dd * 256) = sn; }
#pragma unroll
        for (int j = 0; j < 4; ++j) *(LAS f32x4*)(part + (g * 4 + j) * 256 + v4) = pt[j];
    }
    __syncthreads();
    { const int e = tid * 2, i = e >> 8, v = e & 255; float o0 = 0.f, o1 = 0.f;
#pragma unroll
      for (int g = 0; g < 8; ++g) { o0 += part[(g * 4 + i) * 256 + v]; o1 += part[(g * 4 + i) * 256 + v + 1]; }
#pragma unroll
      for (int j = 0; j < 4; ++j) { const float p = (j <= i) ? Pm[i * 4 + j] : 0.f; o0 += p * vf[j * 256 + v]; o1 += p * vf[j * 256 + v + 1]; }
      *(unsigned*)(OB + (r0 + i) * 1024 + h * 256 + v) = pk2(o0, o1); }
    __syncthreads();
}

__device__ __forceinline__ void gnorm_row(const bf16* orow, const bf16* rsrow, const float* ng, bf16* arow, int lane) {
    const v4u o0 = *(const v4u*)(orow + lane * 16), o1 = *(const v4u*)(orow + lane * 16 + 8);
    const v4u r0 = *(const v4u*)(rsrow + lane * 16), r1 = *(const v4u*)(rsrow + lane * 16 + 8);
    float ov[16], rv[16];
#pragma unroll
    for (int e = 0; e < 4; ++e) { ov[2 * e] = bf2f(o0[e] & 0xffffu); ov[2 * e + 1] = bf2f(o0[e] >> 16); ov[8 + 2 * e] = bf2f(o1[e] & 0xffffu); ov[8 + 2 * e + 1] = bf2f(o1[e] >> 16);
                                  rv[2 * e] = bf2f(r0[e] & 0xffffu); rv[2 * e + 1] = bf2f(r0[e] >> 16); rv[8 + 2 * e] = bf2f(r1[e] & 0xffffu); rv[8 + 2 * e + 1] = bf2f(r1[e] >> 16); }
    float ss = 0.f;
#pragma unroll
    for (int e = 0; e < 16; ++e) ss += ov[e] * ov[e];
#pragma unroll
    for (int o = 1; o < 16; o <<= 1) ss += __shfl_xor(ss, o);
    const float rs = 1.f / sqrtf(ss * (1.f / 256.f) + RMS_EPS);
    v4u w0, w1;
#pragma unroll
    for (int e = 0; e < 4; ++e) { const f32x4 g0 = *(const f32x4*)(ng + lane * 16 + 4 * e);
        const float a = ov[4 * e] * rs * g0.x * rv[4 * e], b = ov[4 * e + 1] * rs * g0.y * rv[4 * e + 1], c = ov[4 * e + 2] * rs * g0.z * rv[4 * e + 2], d = ov[4 * e + 3] * rs * g0.w * rv[4 * e + 3];
        if (e < 2) { w0[2 * e] = pk2(a, b); w0[2 * e + 1] = pk2(c, d); } else { w1[2 * (e - 2)] = pk2(a, b); w1[2 * (e - 2) + 1] = pk2(c, d); } }
    *(v4u*)(arow + lane * 16) = w0; *(v4u*)(arow + lane * 16 + 8) = w1;
}

__device__ __forceinline__ void load16(const bf16* p, float (&v)[16]) {
    const v4u a = *(const v4u*)p, b = *(const v4u*)(p + 8);
#pragma unroll
    for (int e = 0; e < 4; ++e) { v[2 * e] = bf2f(a[e] & 0xffffu); v[2 * e + 1] = bf2f(a[e] >> 16); v[8 + 2 * e] = bf2f(b[e] & 0xffffu); v[8 + 2 * e + 1] = bf2f(b[e] >> 16); }
}
__device__ __forceinline__ void loadf16(const float* p, float (&v)[16]) {
#pragma unroll
    for (int e = 0; e < 4; ++e) { const f32x4 a = *(const f32x4*)(p + 4 * e); v[4 * e] = a.x; v[4 * e + 1] = a.y; v[4 * e + 2] = a.z; v[4 * e + 3] = a.w; }
}
__device__ __forceinline__ void conv_row(int row, const bf16* BCH, const float* wconv, const float* st_conv, bf16* A3, float* out, int lane) {
    const int c0 = lane * 16;
    int t, T; size_t rb; const float* hist = nullptr; float* so;
    if (row < NP) { t = row & (SEQ - 1); T = SEQ; rb = (size_t)row - t; so = out + O_CONVP + (size_t)(row >> 11) * 2 * D; }
    else { const int q = row - NP; t = q & 3; T = 4; rb = (size_t)row - t; hist = st_conv + (size_t)(q >> 2) * 2 * D; so = out + O_CONVS + (size_t)(q >> 2) * 2 * D; }
    float bgv[16], u0[16], u1[16], u2[16], a[16], b[16];
    load16(BCH + (size_t)row * 3072 + c0, bgv);
    load16(BCH + (size_t)row * 3072 + 1024 + c0, a); load16(BCH + (size_t)row * 3072 + 2048 + c0, b);
#pragma unroll
    for (int e = 0; e < 16; ++e) u2[e] = a[e] * b[e];
    if (t >= 1) { load16(BCH + (rb + t - 1) * 3072 + 1024 + c0, a); load16(BCH + (rb + t - 1) * 3072 + 2048 + c0, b);
#pragma unroll
        for (int e = 0; e < 16; ++e) u1[e] = a[e] * b[e]; }
    else if (hist) loadf16(hist + D + c0, u1);
    else {
#pragma unroll
        for (int e = 0; e < 16; ++e) u1[e] = 0.f; }
    if (t >= 2) { load16(BCH + (rb + t - 2) * 3072 + 1024 + c0, a); load16(BCH + (rb + t - 2) * 3072 + 2048 + c0, b);
#pragma unroll
        for (int e = 0; e < 16; ++e) u0[e] = a[e] * b[e]; }
    else if (hist) loadf16(hist + (size_t)t * D + c0, u0);
    else {
#pragma unroll
        for (int e = 0; e < 16; ++e) u0[e] = 0.f; }
    float w0[16], w1[16], w2[16];
    loadf16(wconv + c0, w0); loadf16(wconv + D + c0, w1); loadf16(wconv + 2 * D + c0, w2);
    v4u o0, o1;
#pragma unroll
    for (int e = 0; e < 4; ++e) {
        float r[4];
#pragma unroll
        for (int q = 0; q < 4; ++q) { const int i = 4 * e + q; r[q] = bgv[i] * (u0[i] * w0[i] + u1[i] * w1[i] + u2[i] * w2[i]); }
        if (e < 2) { o0[2 * e] = pk2(r[0], r[1]); o0[2 * e + 1] = pk2(r[2], r[3]); } else { o1[2 * (e - 2)] = pk2(r[0], r[1]); o1[2 * (e - 2) + 1] = pk2(r[2], r[3]); } }
    *(v4u*)(A3 + (size_t)row * D + c0) = o0; *(v4u*)(A3 + (size_t)row * D + c0 + 8) = o1;
    if (t >= T - 2) { float* sp = so + (size_t)(t - (T - 2)) * D + c0;
#pragma unroll
        for (int e = 0; e < 4; ++e) *(f32x4*)(sp + 4 * e) = (f32x4){u2[4 * e], u2[4 * e + 1], u2[4 * e + 2], u2[4 * e + 3]}; }
}

struct Args { const float* in[18]; float* out; unsigned char* ws; };

__global__ void __launch_bounds__(NT, 2) mega_fwd(Args args) {
    extern __shared__ __attribute__((aligned(16))) unsigned char lds_raw[];
    LAS unsigned char* lds = (LAS unsigned char*)lds_raw;
    cg::grid_group grid = cg::this_grid();
    const int tid = threadIdx.x, lane = tid & 63, wave = __builtin_amdgcn_readfirstlane(tid >> 6);
    const int G = gridDim.x, bx = blockIdx.x;
    const int gw = bx * NWAVES + wave, NGW = G * NWAVES;
    unsigned char* ws = args.ws; float* out = args.out;
    const float *x_p = args.in[0], *x_s = args.in[1], *st_gla = args.in[2], *st_conv = args.in[3], *gla_w_in = args.in[4], *gla_w_up = args.in[5], *gla_bg = args.in[6], *gla_ng = args.in[7],
                *gla_w_o = args.in[8], *conv_w_in = args.in[9], *conv_w_conv = args.in[10], *conv_w_out = args.in[11], *mlp_up = args.in[12], *mlp_dn = args.in[13],
                *ln1_g = args.in[14], *ln1_b = args.in[15], *ln2_g = args.in[16], *ln2_b = args.in[17];
    bf16 *Wgin = (bf16*)(ws + WS_WGIN), *Wcin = (bf16*)(ws + WS_WCIN), *Wo = (bf16*)(ws + WS_WO), *Wout = (bf16*)(ws + WS_WOUT);
    bf16 *Wup0 = (bf16*)(ws + WS_WUP0), *Wup1 = (bf16*)(ws + WS_WUP1), *Wdn0 = (bf16*)(ws + WS_WDN0), *Wdn1 = (bf16*)(ws + WS_WDN1);
    bf16 *R0 = (bf16*)(ws + WS_R0), *R1 = (bf16*)(ws + WS_R1);
    float* Bc = (float*)(ws + WS_R1);
    bf16 *QD = (bf16*)(ws + WS_QD), *KD = (bf16*)(ws + WS_KD), *KS = (bf16*)(ws + WS_KS), *Vb = (bf16*)(ws + WS_V), *RS = (bf16*)(ws + WS_RS), *H = (bf16*)(ws + WS_H);
    float* Z = out + O_Y;

    {
        LAS float* scr = (LAS float*)(lds + wave * 16384);
        constexpr int I_GIN = (D / 64) * (3072 / 32), I_SQ = (D / 64) * (D / 32), I_UP = (D / 64) * (FF / 32), I_DN = (FF / 64) * (D / 32);
        constexpr int NITEMS = 2 * I_GIN + 2 * I_SQ + 2 * I_UP + 2 * I_DN;
        for (int it = gw; it < NITEMS; it += NGW) {
            int r = it;
            if (r < I_GIN) { transpose_item(gla_w_in, D, 3072, GIN, Wgin, scr, r, lane); continue; } r -= I_GIN;
            if (r < I_GIN) { transpose_item(conv_w_in, D, 3072, 3072, Wcin, scr, r, lane); continue; } r -= I_GIN;
            if (r < I_SQ) { transpose_item(gla_w_o, D, D, D, Wo, scr, r, lane); continue; } r -= I_SQ;
            if (r < I_SQ) { transpose_item(conv_w_out, D, D, D, Wout, scr, r, lane); continue; } r -= I_SQ;
            if (r < I_UP) { transpose_item(mlp_up, D, FF, FF, Wup0, scr, r, lane); continue; } r -= I_UP;
            if (r < I_UP) { transpose_item(mlp_up + (size_t)D * FF, D, FF, FF, Wup1, scr, r, lane); continue; } r -= I_UP;
            if (r < I_DN) { transpose_item(mlp_dn, FF, D, D, Wdn0, scr, r, lane); continue; } r -= I_DN;
            transpose_item(mlp_dn + (size_t)D * FF, FF, D, D, Wdn1, scr, r, lane);
        }
        for (int m = gw; m < M; m += NGW) {
            const float* xr = (m < NP) ? x_p + (size_t)m * D : x_s + (size_t)(m - NP) * D;
#pragma unroll
            for (int j = 0; j < 4; ++j) { const f32x4 v = ((const f32x4*)xr)[lane + 64 * j]; v2u w; w.x = pk2(v.x, v.y); w.y = pk2(v.z, v.w); ((v2u*)(R0 + (size_t)m * D))[lane + 64 * j] = w; }
        }
        __syncthreads();
        for (int it = bx; it < M / 64; it += G) gate_item(lds, it, x_p, x_s, gla_w_in, gla_w_up, gla_bg, Bc, tid);
    }
    grid.sync();
    { pg8::Gemm g{R0, Wgin, M, 3072, D}; pg8::StaticOrder S; S.init(M, 3072, G, bx);
      pg8::EpiGlaIn E{QD, KD, KS, Vb, RS, Bc};
      pg8::gemm_phase<pg8::EpiGlaIn, pg8::StaticOrder, true, true>(lds, g, S, E); }
    grid.sync();
    {
        for (int it = bx; it < 256; it += G) gla_prompt_item(lds, it, QD, KD, KS, Vb, Bc, R0, out + O_GLAP, tid);
        for (int it = bx; it < 512; it += G) gla_sample_item(lds, it, QD, KD, KS, Vb, Bc, st_gla, R0, out + O_GLAS, tid);
    }
    grid.sync();
    for (int m = gw; m < M; m += NGW) gnorm_row(R0 + (size_t)m * D, RS + (size_t)m * D, gla_ng, R1 + (size_t)m * D, lane);
    grid.sync();
    { pg8::Gemm g{R1, Wo, M, D, D}; pg8::StaticOrder S; S.init(M, D, G, bx);
      pg8::EpiResid E{Z, x_p, x_s, nullptr, ALPHA};
      pg8::gemm_phase<pg8::EpiResid, pg8::StaticOrder, true, true>(lds, g, S, E); }
    grid.sync();
    for (int m = gw; m < M; m += NGW) ln_row<false>(Z + (size_t)m * D, ln1_g, ln1_b, R0 + (size_t)m * D, lane);
    grid.sync();
    { pg8::Gemm g{R0, Wup0, M, FF, D}; pg8::StaticOrder S; S.init(M, FF, G, bx);
      pg8::EpiStore<1> E{H, FF};
      pg8::gemm_phase<pg8::EpiStore<1>, pg8::StaticOrder, true, true>(lds, g, S, E); }
    grid.sync();
    { pg8::Gemm g{H, Wdn0, M, D, FF}; pg8::StaticOrder S; S.init(M, D, G, bx);
      pg8::EpiResid E{Z, nullptr, nullptr, R0, ALPHA};
      pg8::gemm_phase<pg8::EpiResid, pg8::StaticOrder, true, true>(lds, g, S, E); }
    grid.sync();
    for (int m = gw; m < M; m += NGW) ln_row<false>(Z + (size_t)m * D, ln2_g, ln2_b, R0 + (size_t)m * D, lane);
    grid.sync();
    { pg8::Gemm g{R0, Wcin, M, 3072, D}; pg8::StaticOrder S; S.init(M, 3072, G, bx);
      pg8::EpiStore<0> E{H, 3072};
      pg8::gemm_phase<pg8::EpiStore<0>, pg8::StaticOrder, true, true>(lds, g, S, E); }
    grid.sync();
    for (int m = gw; m < M; m += NGW) conv_row(m, H, conv_w_conv, st_conv, R1, out, lane);
    grid.sync();
    { pg8::Gemm g{R1, Wout, M, D, D}; pg8::StaticOrder S; S.init(M, D, G, bx);
      pg8::EpiResid E{Z, nullptr, nullptr, R0, ALPHA};
      pg8::gemm_phase<pg8::EpiResid, pg8::StaticOrder, true, true>(lds, g, S, E); }
    grid.sync();
    for (int m = gw; m < M; m += NGW) ln_row<false>(Z + (size_t)m * D, ln1_g + D, ln1_b + D, R0 + (size_t)m * D, lane);
    grid.sync();
    { pg8::Gemm g{R0, Wup1, M, FF, D}; pg8::StaticOrder S; S.init(M, FF, G, bx);
      pg8::EpiStore<1> E{H, FF};
      pg8::gemm_phase<pg8::EpiStore<1>, pg8::StaticOrder, true, true>(lds, g, S, E); }
    grid.sync();
    { pg8::Gemm g{H, Wdn1, M, D, FF}; pg8::StaticOrder S; S.init(M, D, G, bx);
      pg8::EpiResid E{Z, nullptr, nullptr, R0, ALPHA};
      pg8::gemm_phase<pg8::EpiResid, pg8::StaticOrder, true, true>(lds, g, S, E); }
    grid.sync();
    for (int m = gw; m < M; m += NGW) ln_row<true>(Z + (size_t)m * D, ln2_g + D, ln2_b + D, Z + (size_t)m * D, lane);
}

extern "C" void kernel_launch(void* const* d_in, const int* in_sizes, int n_in, void* d_out, int out_size, void* d_ws, size_t ws_size, hipStream_t stream) {
    static int grid = 0;
    if (grid == 0) {
        if (n_in != 18 || out_size != 35405824 || ws_size < 256 * MiB) { fprintf(stderr, "kernel_launch: unexpected shapes (n_in %d out %d ws %zu)\n", n_in, out_size, ws_size); grid = -1; return; }
        int dev = 0, cus = 0, per_cu = 0;
        hipGetDevice(&dev); hipDeviceGetAttribute(&cus, hipDeviceAttributeMultiprocessorCount, dev);
        if (hipFuncSetAttribute((const void*)mega_fwd, hipFuncAttributeMaxDynamicSharedMemorySize, LDS_BYTES) != hipSuccess) { fprintf(stderr, "kernel_launch: hipFuncSetAttribute failed\n"); grid = -1; return; }
        if (hipOccupancyMaxActiveBlocksPerMultiprocessor(&per_cu, (const void*)mega_fwd, NT, LDS_BYTES) != hipSuccess || per_cu < 1) { fprintf(stderr, "kernel_launch: occupancy query failed (%d)\n", per_cu); (void)hipGetLastError(); per_cu = 1; }
        grid = cus * (per_cu > 1 ? 1 : per_cu);
    }
    if (grid < 0) return;
    Args a{};
    for (int i = 0; i < 18; ++i) a.in[i] = (const float*)d_in[i];
    a.out = (float*)d_out; a.ws = (unsigned char*)d_ws;
    void* kargs[] = {&a};
    hipError_t e = hipLaunchCooperativeKernel((const void*)mega_fwd, dim3(grid), dim3(NT), kargs, LDS_BYTES, stream);
    if (e != hipSuccess) fprintf(stderr, "kernel_launch: cooperative launch failed: %s (grid %d)\n", hipGetErrorString(e), grid);
}
```

```cpp
#include <hip/hip_runtime.h>
#include <hip/hip_cooperative_groups.h>
#include <cstdio>
#include <cstdint>
namespace cg = cooperative_groups;
namespace pg8 {
#define PG8_LAS __attribute__((address_space(3)))
typedef unsigned short bf16_t;
typedef short bf16x8 __attribute__((ext_vector_type(8)));
typedef float f32x4 __attribute__((ext_vector_type(4)));
typedef unsigned u32x4 __attribute__((ext_vector_type(4)));
constexpr int BM = 256, BK = 64, HALF = 128, HTB = HALF * BK * 2  , STAGE_BYTES = 8 * HTB, NXCD = 8, WGM = 8;

__host__ __device__ __forceinline__ int lds_byte(int r, int c) { const int st = (r >> 4) * 2 + (c >> 5), rr = r & 15, cc = c & 31, ob = rr * 64 + cc * 2; return st * 1024 + (ob ^ (((ob >> 9) & 1) << 5)); }
__host__ __device__ __forceinline__ void stage_rc(int b, int& R, int& C) { const int st = b / 1024, sb = b % 1024, swz = sb ^ (((sb >> 9) & 1) << 5); R = (st >> 1) * 16 + swz / 64; C = (st & 1) * 32 + (swz % 64) / 2; }
__host__ __device__ __forceinline__ int perm32(int rho) { const int n = rho >> 4, i = rho & 15; return 8 * (i >> 2) + 4 * n + (i & 3); }

struct Unit { int pm, pn; };
struct Gemm { const bf16_t* A; const bf16_t* Bt; int M, N, K; };

struct StaticOrder {
    int nM, nN, nwg, G, c;
    __host__ __device__ void init(int M, int N, int G_, int c_) { nM = M / BM; nN = N / BM; nwg = nM * nN; G = G_; c = c_; }
    __host__ __device__ bool next(int i, Unit& u) const {
        const long L = (long)i * G + c; if (L >= nwg) return false;
        int wgid = (int)L; { const int q = nwg / NXCD, r = nwg % NXCD, xcd = wgid % NXCD, off = wgid / NXCD; wgid = (xcd < r ? xcd * (q + 1) : r * (q + 1) + (xcd - r) * q) + off; }
        const int nig = WGM * nN, gid = wgid / nig, fm = gid * WGM, gsz = (nM - fm) < WGM ? (nM - fm) : WGM;
        u.pm = fm + ((wgid % nig) % gsz); u.pn = (wgid % nig) / gsz; return true;
    }
    __device__ __forceinline__ void a_ready(const Unit&) const {}
    __device__ __forceinline__ void done(const Unit&) const {}
};

__device__ __forceinline__ unsigned cvt_pk_bf16(float lo, float hi) { unsigned r; asm volatile("v_cvt_pk_bf16_f32 %0, %1, %2" : "=v"(r) : "v"(lo), "v"(hi)); return r; }
typedef float f32x2 __attribute__((ext_vector_type(2)));
constexpr int NPROMPT = 16384;
__device__ __forceinline__ float bf2f(unsigned h) { return __uint_as_float(h << 16); }
template <int ACT  > struct EpiStore {
    static constexpr bool PERM = true, AFTER_DRAIN = false;
    bf16_t* O; int ldc;
    __device__ __forceinline__ void operator()(const f32x4 (&acc)[2][2][4][2], const Unit& u, int wr, int wc, int fr, int fq) const {
        const int row0 = u.pm * BM + wr * 64 + fr, col0 = u.pn * BM + wc * 32 + 8 * fq;
#pragma unroll
        for (int ai = 0; ai < 2; ++ai)
#pragma unroll
            for (int m = 0; m < 4; ++m) { bf16_t* rowp = O + (size_t)(row0 + ai * HALF + m * 16) * ldc + col0;
#pragma unroll
                for (int bj = 0; bj < 2; ++bj) { f32x4 v0 = acc[ai][bj][m][0], v1 = acc[ai][bj][m][1];
                    if (ACT == 1) {
#pragma unroll
                        for (int e = 0; e < 4; ++e) { float a = fmaxf(v0[e], 0.f), b = fmaxf(v1[e], 0.f); v0[e] = a * a; v1[e] = b * b; } }
                    u32x4 w; w.x = cvt_pk_bf16(v0[0], v0[1]); w.y = cvt_pk_bf16(v0[2], v0[3]); w.z = cvt_pk_bf16(v1[0], v1[1]); w.w = cvt_pk_bf16(v1[2], v1[3]);
                    *(u32x4*)(rowp + bj * HALF) = w; } }
    }
};
struct EpiResid {
    static constexpr bool PERM = true, AFTER_DRAIN = false;
    float* Z; const float* xp; const float* xs; const bf16_t* xb; float alpha;
    __device__ __forceinline__ void operator()(const f32x4 (&acc)[2][2][4][2], const Unit& u, int wr, int wc, int fr, int fq) const {
        const int row0 = u.pm * BM + wr * 64 + fr, col0 = u.pn * BM + wc * 32 + 8 * fq;
#pragma unroll
        for (int ai = 0; ai < 2; ++ai)
#pragma unroll
            for (int m = 0; m < 4; ++m) { const int row = row0 + ai * HALF + m * 16;
#pragma unroll
                for (int bj = 0; bj < 2; ++bj) { const int col = col0 + bj * HALF; f32x4 r0, r1;
                    if (xb) { const u32x4 w = *(const u32x4*)(xb + (size_t)row * 1024 + col);
                        r0 = (f32x4){bf2f(w.x & 0xffffu), bf2f(w.x >> 16), bf2f(w.y & 0xffffu), bf2f(w.y >> 16)};
                        r1 = (f32x4){bf2f(w.z & 0xffffu), bf2f(w.z >> 16), bf2f(w.w & 0xffffu), bf2f(w.w >> 16)}; }
                    else { const float* xr = (row < NPROMPT) ? xp + (size_t)row * 1024 : xs + (size_t)(row - NPROMPT) * 1024;
                        r0 = *(const f32x4*)(xr + col); r1 = *(const f32x4*)(xr + col + 4); }
                    float* zp = Z + (size_t)row * 1024 + col;
                    *(f32x4*)zp = r0 * alpha + acc[ai][bj][m][0]; *(f32x4*)(zp + 4) = r1 * alpha + acc[ai][bj][m][1]; } }
    }
};
struct EpiGlaIn {
    static constexpr bool PERM = true, AFTER_DRAIN = false;
    bf16_t *QD, *KD, *KS, *V, *RS; const float* Bc;
    __device__ __forceinline__ void operator()(const f32x4 (&acc)[2][2][4][2], const Unit& u, int wr, int wc, int fr, int fq) const {
        const int row0 = u.pm * BM + wr * 64 + fr, cw = wc * 32 + 8 * fq, pn = u.pn;
#pragma unroll
        for (int ai = 0; ai < 2; ++ai)
#pragma unroll
            for (int m = 0; m < 4; ++m) { const int row = row0 + ai * HALF + m * 16; const int lrow = (row < NPROMPT) ? (row | 63) : (row | 3);
#pragma unroll
                for (int bj = 0; bj < 2; ++bj) { f32x4 v0 = acc[ai][bj][m][0], v1 = acc[ai][bj][m][1]; u32x4 w;
                    if (pn < 4) {
                        const int cl = (pn & 1) * 256 + bj * HALF + cw;
                        const f32x4 b0 = *(const f32x4*)(Bc + (size_t)row * 512 + cl), b1 = *(const f32x4*)(Bc + (size_t)row * 512 + cl + 4);
                        if (pn < 2) {
#pragma unroll
                            for (int e = 0; e < 4; ++e) { v0[e] = v0[e] * 0.08838834764831845f * __expf(b0[e]); v1[e] = v1[e] * 0.08838834764831845f * __expf(b1[e]); }
                            w.x = cvt_pk_bf16(v0[0], v0[1]); w.y = cvt_pk_bf16(v0[2], v0[3]); w.z = cvt_pk_bf16(v1[0], v1[1]); w.w = cvt_pk_bf16(v1[2], v1[3]);
                            *(u32x4*)(QD + (size_t)row * 512 + cl) = w;
                        } else {
                            const f32x4 l0 = *(const f32x4*)(Bc + (size_t)lrow * 512 + cl), l1 = *(const f32x4*)(Bc + (size_t)lrow * 512 + cl + 4);
                            f32x4 s0, s1;
#pragma unroll
                            for (int e = 0; e < 4; ++e) { s0[e] = v0[e] * __expf(l0[e] - b0[e]); s1[e] = v1[e] * __expf(l1[e] - b1[e]); v0[e] = v0[e] * __expf(-b0[e]); v1[e] = v1[e] * __expf(-b1[e]); }
                            w.x = cvt_pk_bf16(v0[0], v0[1]); w.y = cvt_pk_bf16(v0[2], v0[3]); w.z = cvt_pk_bf16(v1[0], v1[1]); w.w = cvt_pk_bf16(v1[2], v1[3]);
                            *(u32x4*)(KD + (size_t)row * 512 + cl) = w;
                            w.x = cvt_pk_bf16(s0[0], s0[1]); w.y = cvt_pk_bf16(s0[2], s0[3]); w.z = cvt_pk_bf16(s1[0], s1[1]); w.w = cvt_pk_bf16(s1[2], s1[3]);
                            *(u32x4*)(KS + (size_t)row * 512 + cl) = w;
                        }
                    } else {
                        const int cl = ((pn - 4) & 3) * 256 + bj * HALF + cw;
                        if (pn >= 8) {
#pragma unroll
                            for (int e = 0; e < 4; ++e) { v0[e] = v0[e] / (1.f + __expf(-v0[e])); v1[e] = v1[e] / (1.f + __expf(-v1[e])); } }
                        w.x = cvt_pk_bf16(v0[0], v0[1]); w.y = cvt_pk_bf16(v0[2], v0[3]); w.z = cvt_pk_bf16(v1[0], v1[1]); w.w = cvt_pk_bf16(v1[2], v1[3]);
                        if (pn >= 8) *(u32x4*)(RS + (size_t)row * 1024 + cl) = w; else *(u32x4*)(V + (size_t)row * 1024 + cl) = w;
                    } } }
    }
};
template <class Epi, class Sched, bool ALIGN_EPI = false, bool SP2 = false>
__device__ __forceinline__ void gemm_phase(PG8_LAS unsigned char* lds, const Gemm g, const Sched& S, const Epi& E) {
    const int tid = threadIdx.x, wid = __builtin_amdgcn_readfirstlane(tid >> 6), lane = tid & 63, wr = wid >> 2, wc = wid & 3, fr = lane & 15, fq = lane >> 4;
    const int K = g.K, nt = K / BK;
    unsigned voffA[2], voffB[2];
#pragma unroll
    for (int i = 0; i < 2; ++i) { int R, C; stage_rc(tid * 16 + i * 8192, R, C); const int Rb = Epi::PERM ? ((R & ~31) + perm32(R & 31)) : R;
        voffA[i] = (unsigned)(R * K + C) * 2u; voffB[i] = (unsigned)(Rb * K + C) * 2u; }
    const size_t kstep = (size_t)(BK * 2);
    const size_t hstep = (size_t)HALF * K * 2;
    const size_t tstep = 2 * hstep;
    const unsigned ldsw = (unsigned)wid * 1024u;
    const int aoff = lds_byte(wr * 64 + fr, fq * 8), boff = lds_byte(wc * 32 + fr, fq * 8);
#define PG8_SA(b, h) (((b) * 2 + (h)) * HTB)
#define PG8_SB(b, h) ((4 + (b) * 2 + (h)) * HTB)
#define PG8_STAGE(bufoff, gbase, voff) do { _Pragma("unroll") for (int _i = 0; _i < 2; ++_i) \
        __builtin_amdgcn_global_load_lds((const unsigned*)((const char*)(gbase) + (voff)[_i]), (PG8_LAS unsigned*)(lds + (bufoff) + ldsw + _i * 8192), 16, 0, 0); } while (0)
#define PG8_LDA(dst, b, h) do { _Pragma("unroll") for (int m = 0; m < 4; ++m) _Pragma("unroll") for (int k = 0; k < 2; ++k) dst[m][k] = *(const PG8_LAS bf16x8*)(lds + PG8_SA(b, h) + aoff + m * 2048 + k * 1024); } while (0)
#define PG8_LDB(dst, b, h) do { _Pragma("unroll") for (int n = 0; n < 2; ++n) _Pragma("unroll") for (int k = 0; k < 2; ++k) dst[n][k] = *(const PG8_LAS bf16x8*)(lds + PG8_SB(b, h) + boff + n * 2048 + k * 1024); } while (0)
#define PG8_MMA(ai, bj, At, Bt) do { __builtin_amdgcn_s_setprio(1); _Pragma("unroll") for (int m = 0; m < 4; ++m) _Pragma("unroll") for (int n = 0; n < 2; ++n) _Pragma("unroll") for (int k = 0; k < 2; ++k) \
        acc[ai][bj][m][n] = __builtin_amdgcn_mfma_f32_16x16x32_bf16(Bt[n][k], At[m][k], acc[ai][bj][m][n], 0, 0, 0); __builtin_amdgcn_s_setprio(0); } while (0)
#define PG8_WAIT_V(n) asm volatile("s_waitcnt vmcnt(" #n ")" ::: "memory")
#define PG8_WAIT_L(n) asm volatile("s_waitcnt lgkmcnt(" #n ")" ::: "memory")
#define PG8_BAR __builtin_amdgcn_s_barrier()
#define PG8_SCHED __builtin_amdgcn_sched_barrier(0)
    Unit cur, nxt; int ui = 0;
    if (!S.next(0, cur)) return;
    f32x4 acc[2][2][4][2];
#pragma unroll
    for (int a = 0; a < 2; ++a)
#pragma unroll
        for (int b = 0; b < 2; ++b)
#pragma unroll
            for (int m = 0; m < 4; ++m)
#pragma unroll
                for (int n = 0; n < 2; ++n) acc[a][b][m][n] = (f32x4){0.f, 0.f, 0.f, 0.f};
    bf16x8 At[4][2], B0[2][2], B1[2][2];
    const char* cA = (const char*)g.A + (size_t)cur.pm * tstep; const char* cB = (const char*)g.Bt + (size_t)cur.pn * tstep;
    S.a_ready(cur);
    if constexpr (SP2) {
        PG8_STAGE(PG8_SB(0, 0), cB, voffB); PG8_STAGE(PG8_SB(0, 1), cB + hstep, voffB); PG8_STAGE(PG8_SA(0, 0), cA, voffA); PG8_STAGE(PG8_SA(0, 1), cA + hstep, voffA);
        if (wr == 1) PG8_BAR;
        PG8_WAIT_V(2); PG8_BAR;
        PG8_STAGE(PG8_SB(1, 0), cB + kstep, voffB); PG8_STAGE(PG8_SA(1, 0), cA + kstep, voffA); PG8_STAGE(PG8_SB(1, 1), cB + hstep + kstep, voffB);
        PG8_WAIT_V(6); PG8_BAR;
    } else {
        PG8_STAGE(PG8_SB(0, 0), cB, voffB); PG8_STAGE(PG8_SA(0, 0), cA, voffA); PG8_STAGE(PG8_SB(0, 1), cB + hstep, voffB); PG8_STAGE(PG8_SA(0, 1), cA + hstep, voffA);
        if (wr == 1) PG8_BAR;
        PG8_WAIT_V(4); PG8_BAR;
        PG8_STAGE(PG8_SB(1, 0), cB + kstep, voffB); PG8_STAGE(PG8_SA(1, 0), cA + kstep, voffA); PG8_STAGE(PG8_SB(1, 1), cB + hstep + kstep, voffB);
        PG8_WAIT_V(6); PG8_BAR;
    }
    for (;;) {
        const bool has_next = S.next(ui + 1, nxt);
        const char* nA = has_next ? (const char*)g.A + (size_t)nxt.pm * tstep : cA; const char* nB = has_next ? (const char*)g.Bt + (size_t)nxt.pn * tstep : cB;
        for (int t = 0; t < nt; t += 2) {
            const bool last = (t == nt - 2);
            const char* a1 = cA + (size_t)(t + 1) * kstep;
            const char* a2 = last ? nA : cA + (size_t)(t + 2) * kstep; const char* b2 = last ? nB : cB + (size_t)(t + 2) * kstep;
            const char* a3 = a2 + kstep; const char* b3 = b2 + kstep;
            if (last && has_next) S.a_ready(nxt);
            if constexpr (SP2) {
            PG8_LDB(B0, 0, 0); PG8_LDB(B1, 0, 1); PG8_SCHED; PG8_LDA(At, 0, 0); PG8_STAGE(PG8_SA(1, 1), a1 + hstep, voffA);
            PG8_WAIT_V(8); PG8_WAIT_L(0); PG8_BAR; PG8_MMA(0, 0, At, B0); PG8_MMA(0, 1, At, B1); PG8_BAR; PG8_SCHED;
            PG8_LDA(At, 0, 1); PG8_STAGE(PG8_SB(0, 0), b2, voffB); PG8_STAGE(PG8_SB(0, 1), b2 + hstep, voffB); PG8_STAGE(PG8_SA(0, 0), a2, voffA);
            PG8_WAIT_V(8); PG8_WAIT_L(0); PG8_BAR; PG8_MMA(1, 0, At, B0); PG8_MMA(1, 1, At, B1); PG8_BAR; PG8_SCHED;
            PG8_LDB(B0, 1, 0); PG8_LDB(B1, 1, 1); PG8_SCHED; PG8_LDA(At, 1, 0); PG8_STAGE(PG8_SA(0, 1), a2 + hstep, voffA);
            PG8_WAIT_V(8); PG8_WAIT_L(0); PG8_BAR; PG8_MMA(0, 0, At, B0); PG8_MMA(0, 1, At, B1); PG8_BAR; PG8_SCHED;
            PG8_LDA(At, 1, 1); PG8_STAGE(PG8_SB(1, 0), b3, voffB); PG8_STAGE(PG8_SB(1, 1), b3 + hstep, voffB); PG8_STAGE(PG8_SA(1, 0), a3, voffA);
            PG8_WAIT_V(8); PG8_WAIT_L(0); PG8_BAR; PG8_MMA(1, 0, At, B0); PG8_MMA(1, 1, At, B1); PG8_BAR; PG8_SCHED;
            } else {
            PG8_LDB(B0, 0, 0); PG8_SCHED; PG8_LDA(At, 0, 0); PG8_STAGE(PG8_SA(1, 1), a1 + hstep, voffA);
            PG8_WAIT_L(8); PG8_BAR; PG8_WAIT_L(0); PG8_MMA(0, 0, At, B0); PG8_BAR; PG8_SCHED;
            PG8_LDB(B1, 0, 1); PG8_STAGE(PG8_SB(0, 0), b2, voffB);
            PG8_BAR; PG8_WAIT_L(0); PG8_MMA(0, 1, At, B1); PG8_BAR;
            PG8_LDA(At, 0, 1); PG8_STAGE(PG8_SA(0, 0), a2, voffA);
            PG8_BAR; PG8_WAIT_L(0); PG8_MMA(1, 0, At, B0); PG8_BAR; PG8_SCHED;
            PG8_STAGE(PG8_SB(0, 1), b2 + hstep, voffB);
            PG8_WAIT_V(6); PG8_BAR; PG8_MMA(1, 1, At, B1); PG8_BAR;
            PG8_LDB(B0, 1, 0); PG8_SCHED; PG8_LDA(At, 1, 0); PG8_STAGE(PG8_SA(0, 1), a2 + hstep, voffA);
            PG8_WAIT_L(8); PG8_BAR; PG8_WAIT_L(0); PG8_MMA(0, 0, At, B0); PG8_BAR; PG8_SCHED;
            PG8_LDB(B1, 1, 1); PG8_STAGE(PG8_SB(1, 0), b3, voffB);
            PG8_BAR; PG8_WAIT_L(0); PG8_MMA(0, 1, At, B1); PG8_BAR;
            PG8_LDA(At, 1, 1); PG8_STAGE(PG8_SA(1, 0), a3, voffA);
            PG8_BAR; PG8_WAIT_L(0); PG8_MMA(1, 0, At, B0); PG8_BAR; PG8_SCHED;
            PG8_STAGE(PG8_SB(1, 1), b3 + hstep, voffB);
            PG8_WAIT_V(6); PG8_BAR; PG8_MMA(1, 1, At, B1); PG8_BAR;
            }
        }
        if constexpr (ALIGN_EPI) { if (wr == 0) PG8_BAR; }
        if constexpr (!Epi::AFTER_DRAIN) { E(acc, cur, wr, wc, fr, fq); S.done(cur); }
        if (!has_next) break;
#pragma unroll
        for (int a = 0; a < 2; ++a)
#pragma unroll
            for (int b = 0; b < 2; ++b)
#pragma unroll
                for (int m = 0; m < 4; ++m)
#pragma unroll
                    for (int n = 0; n < 2; ++n) acc[a][b][m][n] = (f32x4){0.f, 0.f, 0.f, 0.f};
        cur = nxt; cA = nA; cB = nB; ++ui;
        if constexpr (ALIGN_EPI) { if (wr == 1) PG8_BAR; }
    }
    PG8_WAIT_V(0);
    if constexpr (!ALIGN_EPI) { if (wr == 0) PG8_BAR; }
    PG8_BAR;
    if constexpr (Epi::AFTER_DRAIN) { E.fused(acc, cur, wr, wc, fr, fq, lds, wid, lane); S.done(cur); }
#undef PG8_SA
#undef PG8_SB
#undef PG8_STAGE
#undef PG8_LDA
#undef PG8_LDB
#undef PG8_MMA
#undef PG8_WAIT_V
#undef PG8_WAIT_L
#undef PG8_BAR
#undef PG8_SCHED
}
}
#define LAS __attribute__((address_space(3)))
typedef unsigned short bf16;
typedef float f32x4 __attribute__((ext_vector_type(4)));
typedef short bf16x8 __attribute__((ext_vector_type(8)));
typedef unsigned v4u __attribute__((ext_vector_type(4)));
typedef unsigned v2u __attribute__((ext_vector_type(2)));

constexpr int NWAVES = 8, NT = NWAVES * 64;
constexpr int D = 1024, NP = 16384, NS = 512, M = NP + NS, FF = 4096, SEQ = 2048;
constexpr int GIN = 3088;
constexpr float ALPHA = 1.4142135623730951f, LN_EPS = 1e-5f, RMS_EPS = 1e-6f;
constexpr int LDS_BYTES = 147456, MISC_OFF = 131072 + 8192;
constexpr size_t O_Y = 0, O_GLAP = 17301504, O_GLAS = 18350080, O_CONVP = 35127296, O_CONVS = 35143680;
constexpr size_t MiB = 1u << 20;
constexpr size_t WS_WGIN = 1 * MiB, WS_WCIN = 7 * MiB, WS_WO = 13 * MiB, WS_WOUT = 15 * MiB, WS_WUP0 = 17 * MiB, WS_WUP1 = 25 * MiB, WS_WDN0 = 33 * MiB, WS_WDN1 = 41 * MiB;
constexpr size_t WS_R0 = 49 * MiB;
constexpr size_t WS_R1 = 82 * MiB;
constexpr size_t WS_QD = 115 * MiB, WS_KD = WS_QD + (size_t)M * 512 * 2, WS_KS = WS_KD + (size_t)M * 512 * 2, WS_V = WS_KS + (size_t)M * 512 * 2, WS_RS = WS_V + (size_t)M * 1024 * 2;
constexpr size_t WS_H = 115 * MiB;
static_assert(WS_RS + (size_t)M * 1024 * 2 <= 256 * MiB && WS_H + (size_t)M * FF * 2 <= 256 * MiB, "ws map");

__device__ __forceinline__ float bf2f(unsigned h) { return __uint_as_float(h << 16); }
__device__ __forceinline__ unsigned f2bf(float f) { unsigned u = __builtin_bit_cast(unsigned, f); return (u + 0x7fffu + ((u >> 16) & 1u)) >> 16; }
__device__ __forceinline__ unsigned pk2(float lo, float hi) { return f2bf(lo) | (f2bf(hi) << 16); }
__device__ __forceinline__ float wave_sum(float v) {
#pragma unroll
    for (int o = 1; o < 64; o <<= 1) v += __shfl_xor(v, o);
    return v;
}
#define LDS_WAIT() asm volatile("s_waitcnt lgkmcnt(0)" ::: "memory")

__device__ __forceinline__ void transpose_item(const float* W, int K, int N, int ld, bf16* WT, LAS float* scr, int item, int lane) {
    const int nblk = N / 32, kb = item / nblk, nb = item % nblk, k0 = 64 * kb, n0 = 32 * nb;
#pragma unroll 8
    for (int i = 0; i < 32; ++i) { const int kk = 2 * i + (lane >> 5); scr[kk * 33 + (lane & 31)] = W[(size_t)(k0 + kk) * ld + n0 + (lane & 31)]; }
    LDS_WAIT(); asm volatile("" ::: "memory");
    const int c = lane & 7;
#pragma unroll
    for (int j = 0; j < 4; ++j) { const int n = (lane >> 3) + 8 * j; const LAS float* s = scr + (8 * c) * 33 + n;
        v4u o; o.x = pk2(s[0 * 33], s[1 * 33]); o.y = pk2(s[2 * 33], s[3 * 33]); o.z = pk2(s[4 * 33], s[5 * 33]); o.w = pk2(s[6 * 33], s[7 * 33]);
        *(v4u*)(WT + (size_t)(n0 + n) * K + k0 + 8 * c) = o; }
    LDS_WAIT(); asm volatile("" ::: "memory");
}

template <bool OUT_F32>
__device__ __forceinline__ void ln_row(const float* zrow, const float* g, const float* bta, void* orow, int lane) {
    const f32x4* xr = (const f32x4*)zrow + lane;
    f32x4 v[4]; float s = 0.f;
#pragma unroll
    for (int j = 0; j < 4; ++j) { v[j] = xr[64 * j]; s += (v[j].x + v[j].y) + (v[j].z + v[j].w); }
    const float mean = wave_sum(s) * (1.f / D); float s2 = 0.f;
#pragma unroll
    for (int j = 0; j < 4; ++j) { v[j] = v[j] - mean; s2 += (v[j].x * v[j].x + v[j].y * v[j].y) + (v[j].z * v[j].z + v[j].w * v[j].w); }
    const float rstd = 1.f / sqrtf(wave_sum(s2) * (1.f / D) + LN_EPS);
#pragma unroll
    for (int j = 0; j < 4; ++j) { const f32x4 gg = ((const f32x4*)g)[lane + 64 * j], bb = ((const f32x4*)bta)[lane + 64 * j]; const f32x4 o = v[j] * rstd * gg + bb;
        if (OUT_F32) ((f32x4*)orow)[lane + 64 * j] = o;
        else { v2u w; w.x = pk2(o.x, o.y); w.y = pk2(o.z, o.w); ((v2u*)orow)[lane + 64 * j] = w; } }
}
__device__ __forceinline__ float logsig(float x) { return fminf(x, 0.f) - log1pf(expf(-fabsf(x))); }

__device__ __forceinline__ void gate_item(LAS unsigned char* lds, int item, const float* xp, const float* xs, const float* w_in, const float* w_up, const float* b_gate, float* Bc, int tid) {
    LAS float* Wgl = (LAS float*)lds;
    LAS float* gl = (LAS float*)(lds + 65536);
    const int R0 = item * 64; const bool samp = R0 >= NP;
    const float* xbase = samp ? xs + (size_t)(R0 - NP) * D : xp + (size_t)R0 * D;
    for (int e = tid; e < 1024 * 16; e += NT) Wgl[e] = w_in[(size_t)(e >> 4) * GIN + 3072 + (e & 15)];
    __syncthreads();
    {
        const int r = tid >> 3, t8 = tid & 7;
        f32x4 a0 = {0.f, 0.f, 0.f, 0.f}, a1 = a0, a2 = a0, a3 = a0;
        const float* xr = xbase + (size_t)r * D;
#pragma unroll 4
        for (int it = 0; it < 32; ++it) { const int k4 = (it * 8 + t8) * 4; const f32x4 xv = *(const f32x4*)(xr + k4);
#pragma unroll
            for (int kk = 0; kk < 4; ++kk) { const LAS f32x4* wr_ = (const LAS f32x4*)(Wgl + (k4 + kk) * 16); const float xe = xv[kk];
                a0 += wr_[0] * xe; a1 += wr_[1] * xe; a2 += wr_[2] * xe; a3 += wr_[3] * xe; } }
#pragma unroll
        for (int o = 1; o < 8; o <<= 1) {
#pragma unroll
            for (int e = 0; e < 4; ++e) { a0[e] += __shfl_xor(a0[e], o); a1[e] += __shfl_xor(a1[e], o); a2[e] += __shfl_xor(a2[e], o); a3[e] += __shfl_xor(a3[e], o); } }
        if (t8 == 0) { LAS f32x4* gp = (LAS f32x4*)(gl + r * 16); gp[0] = a0; gp[1] = a1; gp[2] = a2; gp[3] = a3; }
    }
    __syncthreads();
    {
        const int c = tid; float wu[16];
#pragma unroll
        for (int j = 0; j < 16; ++j) wu[j] = w_up[j * 512 + c];
        const float bg = b_gate[c]; float run = 0.f;
        for (int r = 0; r < 64; ++r) { const LAS f32x4* gp = (const LAS f32x4*)(gl + r * 16); float pre = bg;
#pragma unroll
            for (int q = 0; q < 4; ++q) { const f32x4 gv = gp[q]; pre += gv.x * wu[4 * q] + gv.y * wu[4 * q + 1] + gv.z * wu[4 * q + 2] + gv.w * wu[4 * q + 3]; }
            const float g = logsig(pre) * 0.0625f;
            if (samp && (r & 3) == 0) run = 0.f;
            run += g; Bc[(size_t)(R0 + r) * 512 + c] = run; }
    }
    __syncthreads();
}

#define MFMA16(a, b, c) __builtin_amdgcn_mfma_f32_16x16x32_bf16((a), (b), (c), 0, 0, 0)
__device__ __forceinline__ void gla_prompt_item(LAS unsigned char* lds, int item, const bf16* QD, const bf16* KD, const bf16* KS, const bf16* V, const float* Bc, bf16* OB, float* gla_p, int tid) {
    const int wid = __builtin_amdgcn_readfirstlane(tid >> 6), lane = tid & 63, l16 = lane & 15, quad = lane >> 4;
    const int s = item & 7, h = (item >> 3) & 3, b = item >> 5;
    LAS bf16* Vt = (LAS bf16*)lds;
    LAS bf16* KSt = (LAS bf16*)(lds + 4608);
    LAS bf16* Pb = (LAS bf16*)(lds + 23040);
    LAS bf16* St = (LAS bf16*)(lds + 32256);
    f32x4 S0 = {0.f, 0.f, 0.f, 0.f}, S1 = S0;
    const int ib = wid >> 1, jb0 = (wid & 1) * 2, vb = wid & 1;
    for (int n = 0; n < 32; ++n) {
        const size_t r0 = (size_t)b * SEQ + n * 64;
        { const int j = tid >> 3, c4 = (tid & 7) * 4;
          const v2u vv = *(const v2u*)(V + (r0 + j) * 1024 + h * 256 + s * 32 + c4);
          Vt[(c4 + 0) * 72 + j] = (bf16)(vv.x & 0xffffu); Vt[(c4 + 1) * 72 + j] = (bf16)(vv.x >> 16); Vt[(c4 + 2) * 72 + j] = (bf16)(vv.y & 0xffffu); Vt[(c4 + 3) * 72 + j] = (bf16)(vv.y >> 16);
          const int c16 = (tid & 7) * 16;
          const v4u k0 = *(const v4u*)(KS + (r0 + j) * 512 + h * 128 + c16), k1 = *(const v4u*)(KS + (r0 + j) * 512 + h * 128 + c16 + 8);
#pragma unroll
          for (int e = 0; e < 4; ++e) { KSt[(c16 + 2 * e) * 72 + j] = (bf16)(k0[e] & 0xffffu); KSt[(c16 + 2 * e + 1) * 72 + j] = (bf16)(k0[e] >> 16);
                                        KSt[(c16 + 8 + 2 * e) * 72 + j] = (bf16)(k1[e] & 0xffffu); KSt[(c16 + 8 + 2 * e + 1) * 72 + j] = (bf16)(k1[e] >> 16); }
          v2u w; w.x = pk2(S0[0], S0[1]); w.y = pk2(S0[2], S0[3]); *(LAS v2u*)(St + l16 * 136 + 16 * wid + quad * 4) = w;
          w.x = pk2(S1[0], S1[1]); w.y = pk2(S1[2], S1[3]); *(LAS v2u*)(St + (16 + l16) * 136 + 16 * wid + quad * 4) = w; }
        bf16x8 qa[4];
        { const bf16* qp = QD + (r0 + ib * 16 + l16) * 512 + h * 128 + quad * 8;
#pragma unroll
          for (int kk = 0; kk < 4; ++kk) qa[kk] = *(const bf16x8*)(qp + kk * 32);
#pragma unroll
          for (int jj = 0; jj < 2; ++jj) { const int jb = jb0 + jj; f32x4 p = {0.f, 0.f, 0.f, 0.f};
              const bf16* kp = KD + (r0 + jb * 16 + l16) * 512 + h * 128 + quad * 8;
#pragma unroll
              for (int kk = 0; kk < 4; ++kk) { const bf16x8 kb = *(const bf16x8*)(kp + kk * 32); p = MFMA16(qa[kk], kb, p); }
#pragma unroll
              for (int t = 0; t < 4; ++t) { const int i = ib * 16 + quad * 4 + t, jcol = jb * 16 + l16; Pb[i * 72 + jcol] = (bf16)f2bf(jcol <= i ? p[t] : 0.f); } } }
        __syncthreads();
        { f32x4 o = {0.f, 0.f, 0.f, 0.f};
#pragma unroll
          for (int kk = 0; kk < 2; ++kk) { const bf16x8 va = *(const LAS bf16x8*)(Vt + (vb * 16 + l16) * 72 + kk * 32 + quad * 8), pbv = *(const LAS bf16x8*)(Pb + (ib * 16 + l16) * 72 + kk * 32 + quad * 8); o = MFMA16(va, pbv, o); }
#pragma unroll
          for (int kk = 0; kk < 4; ++kk) { const bf16x8 sa = *(const LAS bf16x8*)(St + (vb * 16 + l16) * 136 + kk * 32 + quad * 8); o = MFMA16(sa, qa[kk], o); }
          v2u w; w.x = pk2(o[0], o[1]); w.y = pk2(o[2], o[3]);
          *(v2u*)(OB + (r0 + ib * 16 + l16) * 1024 + h * 256 + s * 32 + vb * 16 + quad * 4) = w; }
        { const f32x4 bl = *(const f32x4*)(Bc + (r0 + 63) * 512 + h * 128 + 16 * wid + quad * 4);
#pragma unroll
          for (int t = 0; t < 4; ++t) { const float dc = __expf(bl[t]); S0[t] *= dc; S1[t] *= dc; }
#pragma unroll
          for (int kk = 0; kk < 2; ++kk) { const bf16x8 ka = *(const LAS bf16x8*)(KSt + (16 * wid + l16) * 72 + kk * 32 + quad * 8);
              const bf16x8 v0 = *(const LAS bf16x8*)(Vt + l16 * 72 + kk * 32 + quad * 8), v1 = *(const LAS bf16x8*)(Vt + (16 + l16) * 72 + kk * 32 + quad * 8);
              S0 = MFMA16(ka, v0, S0); S1 = MFMA16(ka, v1, S1); } }
        __syncthreads();
    }
    float* sp = gla_p + ((size_t)(b * 4 + h) * 128 + 16 * wid + quad * 4) * 256 + s * 32 + l16;
#pragma unroll
    for (int t = 0; t < 4; ++t) { sp[(size_t)t * 256] = S0[t]; sp[(size_t)t * 256 + 16] = S1[t]; }
}

__device__ __forceinline__ void gla_sample_item(LAS unsigned char* lds, int item, const bf16* QD, const bf16* KD, const bf16* KS, const bf16* V, const float* Bc, const float* st_in, bf16* OB, float* gla_s, int tid) {
    LAS float* qf = (LAS float*)lds;
    LAS float* kdf = qf + 512;
    LAS float* ksf = kdf + 512;
    LAS float* decf = ksf + 512;
    LAS float* Pm = decf + 128;
    LAS float* vf = Pm + 16;
    LAS float* part = vf + 1024;
    const int b = item >> 2, h = item & 3; const size_t r0 = (size_t)NP + b * 4;
    { const int i = tid >> 7, d = tid & 127; const size_t o = (r0 + i) * 512 + h * 128 + d;
      qf[tid] = bf2f(QD[o]); kdf[tid] = bf2f(KD[o]); ksf[tid] = bf2f(KS[o]);
      if (tid < 128) decf[tid] = __expf(Bc[(r0 + 3) * 512 + h * 128 + tid]);
#pragma unroll
      for (int q = 0; q < 2; ++q) { const int e = tid + q * 512, j = e >> 8, v = e & 255; vf[e] = bf2f(V[(r0 + j) * 1024 + h * 256 + v]); } }
    __syncthreads();
    if (tid < 16) { const int i = tid >> 2, j = tid & 3; float p = 0.f;
        if (j <= i) for (int d = 0; d < 128; ++d) p += qf[i * 128 + d] * kdf[j * 128 + d];
        Pm[tid] = p; }
    {
        const int v4 = (tid & 63) * 4, g = tid >> 6;
        f32x4 vv[4], pt[4];
#pragma unroll
        for (int j = 0; j < 4; ++j) { vv[j] = *(const LAS f32x4*)(vf + j * 256 + v4); pt[j] = (f32x4){0.f, 0.f, 0.f, 0.f}; }
        const size_t sbase = ((size_t)(b * 4 + h) * 128 + g * 16) * 256 + v4;
#pragma unroll 4
        for (int dd = 0; dd < 16; ++dd) { const int d = g * 16 + dd; const f32x4 s0 = *(const f32x4*)(st_in + sbase + (size_t)dd * 256);
            f32x4 sn = s0 * decf[d];
#pragma unroll
            for (int j = 0; j < 4; ++j) { pt[j] += s0 * qf[j * 128 + d]; sn += vv[j] * ksf[j * 128 + d]; }
            *(f32x4*)(gla_s + sbase + (size_t)dd * 256) = sn; }
#pragma unroll
        for (int j = 0; j < 4; ++j) *(LAS f32x4*)(part + (g * 4 + j) * 256 + v4) = pt[j];
    }
    __syncthreads();
    { const int e = tid * 2, i = e >> 8, v = e & 255; float o0 = 0.f, o1 = 0.f;
#pragma unroll
      for (int g = 0; g < 8; ++g) { o0 += part[(g * 4 + i) * 256 + v]; o1 += part[(g * 4 + i) * 256 + v + 1]; }
#pragma unroll
      for (int j = 0; j < 4; ++j) { const float p = (j <= i) ? Pm[i * 4 + j] : 0.f; o0 += p * vf[j * 256 + v]; o1 += p * vf[j * 256 + v + 1]; }
      *(unsigned*)(OB + (r0 + i) * 1024 + h * 256 + v) = pk2(o0, o1); }
    __syncthreads();
}

__device__ __forceinline__ void gnorm_row(const bf16* orow, const bf16* rsrow, const float* ng, bf16* arow, int lane) {
    const v4u o0 = *(const v4u*)(orow + lane * 16), o1 = *(const v4u*)(orow + lane * 16 + 8);
    const v4u r0 = *(const v4u*)(rsrow + lane * 16), r1 = *(const v4u*)(rsrow + lane * 16 + 8);
    float ov[16], rv[16];
#pragma unroll
    for (int e = 0; e < 4; ++e) { ov[2 * e] = bf2f(o0[e] & 0xffffu); ov[2 * e + 1] = bf2f(o0[e] >> 16); ov[8 + 2 * e] = bf2f(o1[e] & 0xffffu); ov[8 + 2 * e + 1] = bf2f(o1[e] >> 16);
                                  rv[2 * e] = bf2f(r0[e] & 0xffffu); rv[2 * e + 1] = bf2f(r0[e] >> 16); rv[8 + 2 * e] = bf2f(r1[e] & 0xffffu); rv[8 + 2 * e + 1] = bf2f(r1[e] >> 16); }
    float ss = 0.f;
#pragma unroll
    for (int e = 0; e < 16; ++e) ss += ov[e] * ov[e];
#pragma unroll
    for (int o = 1; o < 16; o <<= 1) ss += __shfl_xor(ss, o);
    const float rs = 1.f / sqrtf(ss * (1.f / 256.f) + RMS_EPS);
    v4u w0, w1;
#pragma unroll
    for (int e = 0; e < 4; ++e) { const f32x4 g0 = *(const f32x4*)(ng + lane * 16 + 4 * e);
        const float a = ov[4 * e] * rs * g0.x * rv[4 * e], b = ov[4 * e + 1] * rs * g0.y * rv[4 * e + 1], c = ov[4 * e + 2] * rs * g0.z * rv[4 * e + 2], d = ov[4 * e + 3] * rs * g0.w * rv[4 * e + 3];
        if (e < 2) { w0[2 * e] = pk2(a, b); w0[2 * e + 1] = pk2(c, d); } else { w1[2 * (e - 2)] = pk2(a, b); w1[2 * (e - 2) + 1] = pk2(c, d); } }
    *(v4u*)(arow + lane * 16) = w0; *(v4u*)(arow + lane * 16 + 8) = w1;
}

__device__ __forceinline__ void load16(const bf16* p, float (&v)[16]) {
    const v4u a = *(const v4u*)p, b = *(const v4u*)(p + 8);
#pragma unroll
    for (int e = 0; e < 4; ++e) { v[2 * e] = bf2f(a[e] & 0xffffu); v[2 * e + 1] = bf2f(a[e] >> 16); v[8 + 2 * e] = bf2f(b[e] & 0xffffu); v[8 + 2 * e + 1] = bf2f(b[e] >> 16); }
}
__device__ __forceinline__ void loadf16(const float* p, float (&v)[16]) {
#pragma unroll
    for (int e = 0; e < 4; ++e) { const f32x4 a = *(const f32x4*)(p + 4 * e); v[4 * e] = a.x; v[4 * e + 1] = a.y; v[4 * e + 2] = a.z; v[4 * e + 3] = a.w; }
}
__device__ __forceinline__ void conv_row(int row, const bf16* BCH, const float* wconv, const float* st_conv, bf16* A3, float* out, int lane) {
    const int c0 = lane * 16;
    int t, T; size_t rb; const float* hist = nullptr; float* so;
    if (row < NP) { t = row & (SEQ - 1); T = SEQ; rb = (size_t)row - t; so = out + O_CONVP + (size_t)(row >> 11) * 2 * D; }
    else { const int q = row - NP; t = q & 3; T = 4; rb = (size_t)row - t; hist = st_conv + (size_t)(q >> 2) * 2 * D; so = out + O_CONVS + (size_t)(q >> 2) * 2 * D; }
    float bgv[16], u0[16], u1[16], u2[16], a[16], b[16];
    load16(BCH + (size_t)row * 3072 + c0, bgv);
    load16(BCH + (size_t)row * 3072 + 1024 + c0, a); load16(BCH + (size_t)row * 3072 + 2048 + c0, b);
#pragma unroll
    for (int e = 0; e < 16; ++e) u2[e] = a[e] * b[e];
    if (t >= 1) { load16(BCH + (rb + t - 1) * 3072 + 1024 + c0, a); load16(BCH + (rb + t - 1) * 3072 + 2048 + c0, b);
#pragma unroll
        for (int e = 0; e < 16; ++e) u1[e] = a[e] * b[e]; }
    else if (hist) loadf16(hist + D + c0, u1);
    else {
#pragma unroll
        for (int e = 0; e < 16; ++e) u1[e] = 0.f; }
    if (t >= 2) { load16(BCH + (rb + t - 2) * 3072 + 1024 + c0, a); load16(BCH + (rb + t - 2) * 3072 + 2048 + c0, b);
#pragma unroll
        for (int e = 0; e < 16; ++e) u0[e] = a[e] * b[e]; }
    else if (hist) loadf16(hist + (size_t)t * D + c0, u0);
    else {
#pragma unroll
        for (int e = 0; e < 16; ++e) u0[e] = 0.f; }
    float w0[16], w1[16], w2[16];
    loadf16(wconv + c0, w0); loadf16(wconv + D + c0, w1); loadf16(wconv + 2 * D + c0, w2);
    v4u o0, o1;
#pragma unroll
    for (int e = 0; e < 4; ++e) {
        float r[4];
#pragma unroll
        for (int q = 0; q < 4; ++q) { const int i = 4 * e + q; r[q] = bgv[i] * (u0[i] * w0[i] + u1[i] * w1[i] + u2[i] * w2[i]); }
        if (e < 2) { o0[2 * e] = pk2(r[0], r[1]); o0[2 * e + 1] = pk2(r[2], r[3]); } else { o1[2 * (e - 2)] = pk2(r[0], r[1]); o1[2 * (e - 2) + 1] = pk2(r[2], r[3]); } }
    *(v4u*)(A3 + (size_t)row * D + c0) = o0; *(v4u*)(A3 + (size_t)row * D + c0 + 8) = o1;
    if (t >= T - 2) { float* sp = so + (size_t)(t - (T - 2)) * D + c0;
#pragma unroll
        for (int e = 0; e < 4; ++e) *(f32x4*)(sp + 4 * e) = (f32x4){u2[4 * e], u2[4 * e + 1], u2[4 * e + 2], u2[4 * e + 3]}; }
}

#define XB_TMO      128
#define XB_XCNT(j)  (256  + 64 * (j))
#define XB_XSUB(j)  (1280 + 64 * (j))
#define XB_XGEN(j)  (2304 + 64 * (j))
#define XB_TOP      3328
#define XB_TOPGEN   3392
#define XCD_BAR_WORDS 3456
#define XB_SPIN_CAP (1u << 18)

__device__ __forceinline__ unsigned xb_ld(unsigned* p)              { return __hip_atomic_load(p, __ATOMIC_RELAXED, __HIP_MEMORY_SCOPE_AGENT); }
__device__ __forceinline__ unsigned xb_add(unsigned* p, unsigned v) { return __hip_atomic_fetch_add(p, v, __ATOMIC_RELAXED, __HIP_MEMORY_SCOPE_AGENT); }
__device__ __forceinline__ unsigned xb_xcc_id() { return (unsigned)__builtin_amdgcn_s_getreg((3 << 11) | 20) & 0xFu; }
#define XB_SPIN(cond, bar) do { unsigned _sp = 0; while (cond) { __builtin_amdgcn_s_sleep(1); \
    if ((++_sp & 255u) == 0u) { if (xb_ld(&(bar)[XB_TMO])) break; if (_sp > XB_SPIN_CAP) { atomicAdd(&(bar)[XB_TMO], 1u); break; } } } } while (0)

struct XcdBarrier {
    unsigned* bar; unsigned x;
    volatile LAS unsigned* st;
};

__device__ __forceinline__ XcdBarrier xcd_barrier_post(unsigned* bar, volatile LAS unsigned* st) {
    XcdBarrier b; b.bar = bar; b.x = xb_xcc_id(); b.st = st;
    if (threadIdx.x == 0) (void)xb_add(&bar[XB_XCNT(b.x)], 1u);
    return b;
}
__device__ __forceinline__ void xcd_barrier_complete(unsigned* bar, unsigned x, unsigned& nloc, unsigned& nx) {
    const unsigned G = gridDim.x * gridDim.y * gridDim.z;
    unsigned sum, cnt, mine, sp = 0u;
    for (;;) {
        sum = 0u; cnt = 0u; mine = 0u;
#pragma unroll
        for (unsigned j = 0; j < 16; ++j) { const unsigned c = xb_ld(&bar[XB_XCNT(j)]); sum += c; cnt += (c > 0u) ? 1u : 0u; mine = (j == x) ? c : mine; }
        if (sum == G) break;
        __builtin_amdgcn_s_sleep(1);
        if ((++sp & 255u) == 0u) { if (xb_ld(&bar[XB_TMO])) break; if (sp > XB_SPIN_CAP) { atomicAdd(&bar[XB_TMO], 1u); break; } }
    }
    nloc = mine > 0u ? mine : 1u; nx = cnt > 0u ? cnt : 1u;
}

__device__ __forceinline__ void xcd_barrier(const XcdBarrier& b) {
    asm volatile("s_waitcnt vmcnt(0)" ::: "memory");
    __syncthreads();
    if (threadIdx.x == 0) {
        unsigned* bar = b.bar;
        __builtin_amdgcn_s_waitcnt(0);
        unsigned nloc = b.st[0], nx = b.st[1];
        if (nloc == 0u) { xcd_barrier_complete(bar, b.x, nloc, nx); b.st[0] = nloc; b.st[1] = nx; }
        const unsigned old = xb_add(&bar[XB_XSUB(b.x)], 1u);
        const unsigned gen = old / nloc;
        if (old + 1u == (gen + 1u) * nloc) {
            __builtin_amdgcn_fence(__ATOMIC_RELEASE, "agent");
            asm volatile("s_waitcnt vmcnt(0)" ::: "memory");
            const unsigned og = xb_add(&bar[XB_TOP], 1u);
            const unsigned tg = og / nx;
            if (og + 1u == (tg + 1u) * nx) xb_add(&bar[XB_TOPGEN], 1u);
            else XB_SPIN(xb_ld(&bar[XB_TOPGEN]) == tg, bar);
            __builtin_amdgcn_fence(__ATOMIC_ACQUIRE, "agent");
            xb_add(&bar[XB_XGEN(b.x)], 1u);
            asm volatile("s_waitcnt vmcnt(0)" ::: "memory");
        } else {
            XB_SPIN(xb_ld(&bar[XB_XGEN(b.x)]) == gen, bar);
            __builtin_amdgcn_fence(__ATOMIC_ACQUIRE, "agent");
            asm volatile("s_waitcnt vmcnt(0)" ::: "memory");
        }
    }
    __syncthreads();
}

struct Args { const float* in[18]; float* out; unsigned char* ws; };

__global__ void __launch_bounds__(NT, 2) mega_fwd(Args args) {
    extern __shared__ __attribute__((aligned(16))) unsigned char lds_raw[];
    LAS unsigned char* lds = (LAS unsigned char*)lds_raw;
    cg::grid_group grid = cg::this_grid();
    const int tid = threadIdx.x, lane = tid & 63, wave = __builtin_amdgcn_readfirstlane(tid >> 6);
    const int G = gridDim.x, bx = blockIdx.x;
    const int gw = bx * NWAVES + wave, NGW = G * NWAVES;
    unsigned char* ws = args.ws; float* out = args.out;
    const float *x_p = args.in[0], *x_s = args.in[1], *st_gla = args.in[2], *st_conv = args.in[3], *gla_w_in = args.in[4], *gla_w_up = args.in[5], *gla_bg = args.in[6], *gla_ng = args.in[7],
                *gla_w_o = args.in[8], *conv_w_in = args.in[9], *conv_w_conv = args.in[10], *conv_w_out = args.in[11], *mlp_up = args.in[12], *mlp_dn = args.in[13],
                *ln1_g = args.in[14], *ln1_b = args.in[15], *ln2_g = args.in[16], *ln2_b = args.in[17];
    bf16 *Wgin = (bf16*)(ws + WS_WGIN), *Wcin = (bf16*)(ws + WS_WCIN), *Wo = (bf16*)(ws + WS_WO), *Wout = (bf16*)(ws + WS_WOUT);
    bf16 *Wup0 = (bf16*)(ws + WS_WUP0), *Wup1 = (bf16*)(ws + WS_WUP1), *Wdn0 = (bf16*)(ws + WS_WDN0), *Wdn1 = (bf16*)(ws + WS_WDN1);
    bf16 *R0 = (bf16*)(ws + WS_R0), *R1 = (bf16*)(ws + WS_R1);
    float* Bc = (float*)(ws + WS_R1);
    bf16 *QD = (bf16*)(ws + WS_QD), *KD = (bf16*)(ws + WS_KD), *KS = (bf16*)(ws + WS_KS), *Vb = (bf16*)(ws + WS_V), *RS = (bf16*)(ws + WS_RS), *H = (bf16*)(ws + WS_H);
    float* Z = out + O_Y;
    volatile LAS unsigned* MISC = (volatile LAS unsigned*)(lds + MISC_OFF);
    if (tid < 32) MISC[tid] = 0u;
    unsigned* barw = (unsigned*)ws;
    if (bx == 0) for (int u = tid; u < XCD_BAR_WORDS; u += NT) __hip_atomic_store(barw + u, 0u, __ATOMIC_RELAXED, __HIP_MEMORY_SCOPE_AGENT);
    __syncthreads();

    {
        LAS float* scr = (LAS float*)(lds + wave * 16384);
        constexpr int I_GIN = (D / 64) * (3072 / 32), I_SQ = (D / 64) * (D / 32), I_UP = (D / 64) * (FF / 32), I_DN = (FF / 64) * (D / 32);
        constexpr int NITEMS = 2 * I_GIN + 2 * I_SQ + 2 * I_UP + 2 * I_DN;
        for (int it = gw; it < NITEMS; it += NGW) {
            int r = it;
            if (r < I_GIN) { transpose_item(gla_w_in, D, 3072, GIN, Wgin, scr, r, lane); continue; } r -= I_GIN;
            if (r < I_GIN) { transpose_item(conv_w_in, D, 3072, 3072, Wcin, scr, r, lane); continue; } r -= I_GIN;
            if (r < I_SQ) { transpose_item(gla_w_o, D, D, D, Wo, scr, r, lane); continue; } r -= I_SQ;
            if (r < I_SQ) { transpose_item(conv_w_out, D, D, D, Wout, scr, r, lane); continue; } r -= I_SQ;
            if (r < I_UP) { transpose_item(mlp_up, D, FF, FF, Wup0, scr, r, lane); continue; } r -= I_UP;
            if (r < I_UP) { transpose_item(mlp_up + (size_t)D * FF, D, FF, FF, Wup1, scr, r, lane); continue; } r -= I_UP;
            if (r < I_DN) { transpose_item(mlp_dn, FF, D, D, Wdn0, scr, r, lane); continue; } r -= I_DN;
            transpose_item(mlp_dn + (size_t)D * FF, FF, D, D, Wdn1, scr, r, lane);
        }
        for (int m = gw; m < M; m += NGW) {
            const float* xr = (m < NP) ? x_p + (size_t)m * D : x_s + (size_t)(m - NP) * D;
#pragma unroll
            for (int j = 0; j < 4; ++j) { const f32x4 v = ((const f32x4*)xr)[lane + 64 * j]; v2u w; w.x = pk2(v.x, v.y); w.y = pk2(v.z, v.w); ((v2u*)(R0 + (size_t)m * D))[lane + 64 * j] = w; }
        }
        __syncthreads();
        for (int it = bx; it < M / 64; it += G) gate_item(lds, it, x_p, x_s, gla_w_in, gla_w_up, gla_bg, Bc, tid);
    }
    grid.sync();
    const XcdBarrier xbar = xcd_barrier_post(barw, MISC + 8);
    { pg8::Gemm g{R0, Wgin, M, 3072, D}; pg8::StaticOrder S; S.init(M, 3072, G, bx);
      pg8::EpiGlaIn E{QD, KD, KS, Vb, RS, Bc};
      pg8::gemm_phase<pg8::EpiGlaIn, pg8::StaticOrder, true, true>(lds, g, S, E); }
    xcd_barrier(xbar);
    {
        for (int it = bx; it < 256; it += G) gla_prompt_item(lds, it, QD, KD, KS, Vb, Bc, R0, out + O_GLAP, tid);
        for (int it = bx; it < 512; it += G) gla_sample_item(lds, it, QD, KD, KS, Vb, Bc, st_gla, R0, out + O_GLAS, tid);
    }
    xcd_barrier(xbar);
    for (int m = gw; m < M; m += NGW) gnorm_row(R0 + (size_t)m * D, RS + (size_t)m * D, gla_ng, R1 + (size_t)m * D, lane);
    xcd_barrier(xbar);
    { pg8::Gemm g{R1, Wo, M, D, D}; pg8::StaticOrder S; S.init(M, D, G, bx);
      pg8::EpiResid E{Z, x_p, x_s, nullptr, ALPHA};
      pg8::gemm_phase<pg8::EpiResid, pg8::StaticOrder, true, true>(lds, g, S, E); }
    xcd_barrier(xbar);
    for (int m = gw; m < M; m += NGW) ln_row<false>(Z + (size_t)m * D, ln1_g, ln1_b, R0 + (size_t)m * D, lane);
    xcd_barrier(xbar);
    { pg8::Gemm g{R0, Wup0, M, FF, D}; pg8::StaticOrder S; S.init(M, FF, G, bx);
      pg8::EpiStore<1> E{H, FF};
      pg8::gemm_phase<pg8::EpiStore<1>, pg8::StaticOrder, true, true>(lds, g, S, E); }
    xcd_barrier(xbar);
    { pg8::Gemm g{H, Wdn0, M, D, FF}; pg8::StaticOrder S; S.init(M, D, G, bx);
      pg8::EpiResid E{Z, nullptr, nullptr, R0, ALPHA};
      pg8::gemm_phase<pg8::EpiResid, pg8::StaticOrder, true, true>(lds, g, S, E); }
    xcd_barrier(xbar);
    for (int m = gw; m < M; m += NGW) ln_row<false>(Z + (size_t)m * D, ln2_g, ln2_b, R0 + (size_t)m * D, lane);
    xcd_barrier(xbar);
    { pg8::Gemm g{R0, Wcin, M, 3072, D}; pg8::StaticOrder S; S.init(M, 3072, G, bx);
      pg8::EpiStore<0> E{H, 3072};
      pg8::gemm_phase<pg8::EpiStore<0>, pg8::StaticOrder, true, true>(lds, g, S, E); }
    xcd_barrier(xbar);
    for (int m = gw; m < M; m += NGW) conv_row(m, H, conv_w_conv, st_conv, R1, out, lane);
    xcd_barrier(xbar);
    { pg8::Gemm g{R1, Wout, M, D, D}; pg8::StaticOrder S; S.init(M, D, G, bx);
      pg8::EpiResid E{Z, nullptr, nullptr, R0, ALPHA};
      pg8::gemm_phase<pg8::EpiResid, pg8::StaticOrder, true, true>(lds, g, S, E); }
    xcd_barrier(xbar);
    for (int m = gw; m < M; m += NGW) ln_row<false>(Z + (size_t)m * D, ln1_g + D, ln1_b + D, R0 + (size_t)m * D, lane);
    xcd_barrier(xbar);
    { pg8::Gemm g{R0, Wup1, M, FF, D}; pg8::StaticOrder S; S.init(M, FF, G, bx);
      pg8::EpiStore<1> E{H, FF};
      pg8::gemm_phase<pg8::EpiStore<1>, pg8::StaticOrder, true, true>(lds, g, S, E); }
    xcd_barrier(xbar);
    { pg8::Gemm g{H, Wdn1, M, D, FF}; pg8::StaticOrder S; S.init(M, D, G, bx);
      pg8::EpiResid E{Z, nullptr, nullptr, R0, ALPHA};
      pg8::gemm_phase<pg8::EpiResid, pg8::StaticOrder, true, true>(lds, g, S, E); }
    xcd_barrier(xbar);
    for (int m = gw; m < M; m += NGW) ln_row<true>(Z + (size_t)m * D, ln2_g + D, ln2_b + D, Z + (size_t)m * D, lane);
}

extern "C" void kernel_launch(void* const* d_in, const int* in_sizes, int n_in, void* d_out, int out_size, void* d_ws, size_t ws_size, hipStream_t stream) {
    static int grid = 0;
    if (grid == 0) {
        if (n_in != 18 || out_size != 35405824 || ws_size < 256 * MiB) { fprintf(stderr, "kernel_launch: unexpected shapes (n_in %d out %d ws %zu)\n", n_in, out_size, ws_size); grid = -1; return; }
        int dev = 0, cus = 0, per_cu = 0;
        hipGetDevice(&dev); hipDeviceGetAttribute(&cus, hipDeviceAttributeMultiprocessorCount, dev);
        if (hipFuncSetAttribute((const void*)mega_fwd, hipFuncAttributeMaxDynamicSharedMemorySize, LDS_BYTES) != hipSuccess) { fprintf(stderr, "kernel_launch: hipFuncSetAttribute failed\n"); grid = -1; return; }
        if (hipOccupancyMaxActiveBlocksPerMultiprocessor(&per_cu, (const void*)mega_fwd, NT, LDS_BYTES) != hipSuccess || per_cu < 1) { fprintf(stderr, "kernel_launch: occupancy query failed (%d)\n", per_cu); (void)hipGetLastError(); per_cu = 1; }
        grid = cus * (per_cu > 1 ? 1 : per_cu);
    }
    if (grid < 0) return;
    Args a{};
    for (int i = 0; i < 18; ++i) a.in[i] = (const float*)d_in[i];
    a.out = (float*)d_out; a.ws = (unsigned char*)d_ws;
    void* kargs[] = {&a};
    hipError_t e = hipLaunchCooperativeKernel((const void*)mega_fwd, dim3(grid), dim3(NT), kargs, LDS_BYTES, stream);
    if (e != hipSuccess) fprintf(stderr, "kernel_launch: cooperative launch failed: %s (grid %d)\n", hipGetErrorString(e), grid);
}
```

```cpp
#include <hip/hip_runtime.h>
#include <hip/hip_cooperative_groups.h>
#include <cstdio>
#include <cstdint>
namespace cg = cooperative_groups;
namespace pg8 {
#define PG8_LAS __attribute__((address_space(3)))
typedef unsigned short bf16_t;
typedef short bf16x8 __attribute__((ext_vector_type(8)));
typedef float f32x4 __attribute__((ext_vector_type(4)));
typedef unsigned u32x4 __attribute__((ext_vector_type(4)));
constexpr int BM = 256, BK = 64, HALF = 128, HTB = HALF * BK * 2  , STAGE_BYTES = 8 * HTB, NXCD = 8, WGM = 8;

__host__ __device__ __forceinline__ int lds_byte(int r, int c) { const int st = (r >> 4) * 2 + (c >> 5), rr = r & 15, cc = c & 31, ob = rr * 64 + cc * 2; return st * 1024 + (ob ^ (((ob >> 9) & 1) << 5)); }
__host__ __device__ __forceinline__ void stage_rc(int b, int& R, int& C) { const int st = b / 1024, sb = b % 1024, swz = sb ^ (((sb >> 9) & 1) << 5); R = (st >> 1) * 16 + swz / 64; C = (st & 1) * 32 + (swz % 64) / 2; }
__host__ __device__ __forceinline__ int perm32(int rho) { const int n = rho >> 4, i = rho & 15; return 8 * (i >> 2) + 4 * n + (i & 3); }

struct Unit { int pm, pn; };
struct Gemm { const bf16_t* A; const bf16_t* Bt; int M, N, K; };

struct StaticOrder {
    int nM, nN, nwg, G, c;
    __host__ __device__ void init(int M, int N, int G_, int c_) { nM = M / BM; nN = N / BM; nwg = nM * nN; G = G_; c = c_; }
    __host__ __device__ bool next(int i, Unit& u) const {
        const long L = (long)i * G + c; if (L >= nwg) return false;
        int wgid = (int)L; { const int q = nwg / NXCD, r = nwg % NXCD, xcd = wgid % NXCD, off = wgid / NXCD; wgid = (xcd < r ? xcd * (q + 1) : r * (q + 1) + (xcd - r) * q) + off; }
        const int nig = WGM * nN, gid = wgid / nig, fm = gid * WGM, gsz = (nM - fm) < WGM ? (nM - fm) : WGM;
        u.pm = fm + ((wgid % nig) % gsz); u.pn = (wgid % nig) / gsz; return true;
    }
    __device__ __forceinline__ void a_ready(const Unit&) const {}
    __device__ __forceinline__ void done(const Unit&) const {}
};

__device__ __forceinline__ unsigned cvt_pk_bf16(float lo, float hi) { unsigned r; asm volatile("v_cvt_pk_bf16_f32 %0, %1, %2" : "=v"(r) : "v"(lo), "v"(hi)); return r; }
typedef float f32x2 __attribute__((ext_vector_type(2)));
constexpr int NPROMPT = 16384;
__device__ __forceinline__ float bf2f(unsigned h) { return __uint_as_float(h << 16); }
template <int ACT  > struct EpiStore {
    static constexpr bool PERM = true, AFTER_DRAIN = false;
    bf16_t* O; int ldc;
    __device__ __forceinline__ void operator()(const f32x4 (&acc)[2][2][4][2], const Unit& u, int wr, int wc, int fr, int fq) const {
        const int row0 = u.pm * BM + wr * 64 + fr, col0 = u.pn * BM + wc * 32 + 8 * fq;
#pragma unroll
        for (int ai = 0; ai < 2; ++ai)
#pragma unroll
            for (int m = 0; m < 4; ++m) { bf16_t* rowp = O + (size_t)(row0 + ai * HALF + m * 16) * ldc + col0;
#pragma unroll
                for (int bj = 0; bj < 2; ++bj) { f32x4 v0 = acc[ai][bj][m][0], v1 = acc[ai][bj][m][1];
                    if (ACT == 1) {
#pragma unroll
                        for (int e = 0; e < 4; ++e) { float a = fmaxf(v0[e], 0.f), b = fmaxf(v1[e], 0.f); v0[e] = a * a; v1[e] = b * b; } }
                    u32x4 w; w.x = cvt_pk_bf16(v0[0], v0[1]); w.y = cvt_pk_bf16(v0[2], v0[3]); w.z = cvt_pk_bf16(v1[0], v1[1]); w.w = cvt_pk_bf16(v1[2], v1[3]);
                    *(u32x4*)(rowp + bj * HALF) = w; } }
    }
};
struct EpiResid {
    static constexpr bool PERM = true, AFTER_DRAIN = false;
    float* Z; const float* xp; const float* xs; const bf16_t* xb; float alpha;
    __device__ __forceinline__ void operator()(const f32x4 (&acc)[2][2][4][2], const Unit& u, int wr, int wc, int fr, int fq) const {
        const int row0 = u.pm * BM + wr * 64 + fr, col0 = u.pn * BM + wc * 32 + 8 * fq;
#pragma unroll
        for (int ai = 0; ai < 2; ++ai)
#pragma unroll
            for (int m = 0; m < 4; ++m) { const int row = row0 + ai * HALF + m * 16;
#pragma unroll
                for (int bj = 0; bj < 2; ++bj) { const int col = col0 + bj * HALF; f32x4 r0, r1;
                    if (xb) { const u32x4 w = *(const u32x4*)(xb + (size_t)row * 1024 + col);
                        r0 = (f32x4){bf2f(w.x & 0xffffu), bf2f(w.x >> 16), bf2f(w.y & 0xffffu), bf2f(w.y >> 16)};
                        r1 = (f32x4){bf2f(w.z & 0xffffu), bf2f(w.z >> 16), bf2f(w.w & 0xffffu), bf2f(w.w >> 16)}; }
                    else { const float* xr = (row < NPROMPT) ? xp + (size_t)row * 1024 : xs + (size_t)(row - NPROMPT) * 1024;
                        r0 = *(const f32x4*)(xr + col); r1 = *(const f32x4*)(xr + col + 4); }
                    float* zp = Z + (size_t)row * 1024 + col;
                    *(f32x4*)zp = r0 * alpha + acc[ai][bj][m][0]; *(f32x4*)(zp + 4) = r1 * alpha + acc[ai][bj][m][1]; } }
    }
};
struct EpiGlaIn {
    static constexpr bool PERM = true, AFTER_DRAIN = false;
    bf16_t *QD, *KD, *KS, *V, *RS; const float* Bc;
    __device__ __forceinline__ void operator()(const f32x4 (&acc)[2][2][4][2], const Unit& u, int wr, int wc, int fr, int fq) const {
        const int row0 = u.pm * BM + wr * 64 + fr, cw = wc * 32 + 8 * fq, pn = u.pn;
#pragma unroll
        for (int ai = 0; ai < 2; ++ai)
#pragma unroll
            for (int m = 0; m < 4; ++m) { const int row = row0 + ai * HALF + m * 16; const int lrow = (row < NPROMPT) ? (row | 63) : (row | 3);
#pragma unroll
                for (int bj = 0; bj < 2; ++bj) { f32x4 v0 = acc[ai][bj][m][0], v1 = acc[ai][bj][m][1]; u32x4 w;
                    if (pn < 4) {
                        const int cl = (pn & 1) * 256 + bj * HALF + cw;
                        const f32x4 b0 = *(const f32x4*)(Bc + (size_t)row * 512 + cl), b1 = *(const f32x4*)(Bc + (size_t)row * 512 + cl + 4);
                        if (pn < 2) {
#pragma unroll
                            for (int e = 0; e < 4; ++e) { v0[e] = v0[e] * 0.08838834764831845f * __expf(b0[e]); v1[e] = v1[e] * 0.08838834764831845f * __expf(b1[e]); }
                            w.x = cvt_pk_bf16(v0[0], v0[1]); w.y = cvt_pk_bf16(v0[2], v0[3]); w.z = cvt_pk_bf16(v1[0], v1[1]); w.w = cvt_pk_bf16(v1[2], v1[3]);
                            *(u32x4*)(QD + (size_t)row * 512 + cl) = w;
                        } else {
                            const f32x4 l0 = *(const f32x4*)(Bc + (size_t)lrow * 512 + cl), l1 = *(const f32x4*)(Bc + (size_t)lrow * 512 + cl + 4);
                            f32x4 s0, s1;
#pragma unroll
                            for (int e = 0; e < 4; ++e) { s0[e] = v0[e] * __expf(l0[e] - b0[e]); s1[e] = v1[e] * __expf(l1[e] - b1[e]); v0[e] = v0[e] * __expf(-b0[e]); v1[e] = v1[e] * __expf(-b1[e]); }
                            w.x = cvt_pk_bf16(v0[0], v0[1]); w.y = cvt_pk_bf16(v0[2], v0[3]); w.z = cvt_pk_bf16(v1[0], v1[1]); w.w = cvt_pk_bf16(v1[2], v1[3]);
                            *(u32x4*)(KD + (size_t)row * 512 + cl) = w;
                            w.x = cvt_pk_bf16(s0[0], s0[1]); w.y = cvt_pk_bf16(s0[2], s0[3]); w.z = cvt_pk_bf16(s1[0], s1[1]); w.w = cvt_pk_bf16(s1[2], s1[3]);
                            *(u32x4*)(KS + (size_t)row * 512 + cl) = w;
                        }
                    } else {
                        const int cl = ((pn - 4) & 3) * 256 + bj * HALF + cw;
                        if (pn >= 8) {
#pragma unroll
                            for (int e = 0; e < 4; ++e) { v0[e] = v0[e] / (1.f + __expf(-v0[e])); v1[e] = v1[e] / (1.f + __expf(-v1[e])); } }
                        w.x = cvt_pk_bf16(v0[0], v0[1]); w.y = cvt_pk_bf16(v0[2], v0[3]); w.z = cvt_pk_bf16(v1[0], v1[1]); w.w = cvt_pk_bf16(v1[2], v1[3]);
                        if (pn >= 8) *(u32x4*)(RS + (size_t)row * 1024 + cl) = w; else *(u32x4*)(V + (size_t)row * 1024 + cl) = w;
                    } } }
    }
};
template <class Epi, class Sched, bool ALIGN_EPI = false, bool SP2 = false>
__device__ __forceinline__ void gemm_phase(PG8_LAS unsigned char* lds, const Gemm g, const Sched& S, const Epi& E) {
    const int tid = threadIdx.x, wid = __builtin_amdgcn_readfirstlane(tid >> 6), lane = tid & 63, wr = wid >> 2, wc = wid & 3, fr = lane & 15, fq = lane >> 4;
    const int K = g.K, nt = K / BK;
    unsigned voffA[2], voffB[2];
#pragma unroll
    for (int i = 0; i < 2; ++i) { int R, C; stage_rc(tid * 16 + i * 8192, R, C); const int Rb = Epi::PERM ? ((R & ~31) + perm32(R & 31)) : R;
        voffA[i] = (unsigned)(R * K + C) * 2u; voffB[i] = (unsigned)(Rb * K + C) * 2u; }
    const size_t kstep = (size_t)(BK * 2);
    const size_t hstep = (size_t)HALF * K * 2;
    const size_t tstep = 2 * hstep;
    const unsigned ldsw = (unsigned)wid * 1024u;
    const int aoff = lds_byte(wr * 64 + fr, fq * 8), boff = lds_byte(wc * 32 + fr, fq * 8);
#define PG8_SA(b, h) (((b) * 2 + (h)) * HTB)
#define PG8_SB(b, h) ((4 + (b) * 2 + (h)) * HTB)
#define PG8_STAGE(bufoff, gbase, voff) do { _Pragma("unroll") for (int _i = 0; _i < 2; ++_i) \
        __builtin_amdgcn_global_load_lds((const unsigned*)((const char*)(gbase) + (voff)[_i]), (PG8_LAS unsigned*)(lds + (bufoff) + ldsw + _i * 8192), 16, 0, 0); } while (0)
#define PG8_LDA(dst, b, h) do { _Pragma("unroll") for (int m = 0; m < 4; ++m) _Pragma("unroll") for (int k = 0; k < 2; ++k) dst[m][k] = *(const PG8_LAS bf16x8*)(lds + PG8_SA(b, h) + aoff + m * 2048 + k * 1024); } while (0)
#define PG8_LDB(dst, b, h) do { _Pragma("unroll") for (int n = 0; n < 2; ++n) _Pragma("unroll") for (int k = 0; k < 2; ++k) dst[n][k] = *(const PG8_LAS bf16x8*)(lds + PG8_SB(b, h) + boff + n * 2048 + k * 1024); } while (0)
#define PG8_MMA(ai, bj, At, Bt) do { __builtin_amdgcn_s_setprio(1); _Pragma("unroll") for (int m = 0; m < 4; ++m) _Pragma("unroll") for (int n = 0; n < 2; ++n) _Pragma("unroll") for (int k = 0; k < 2; ++k) \
        acc[ai][bj][m][n] = __builtin_amdgcn_mfma_f32_16x16x32_bf16(Bt[n][k], At[m][k], acc[ai][bj][m][n], 0, 0, 0); __builtin_amdgcn_s_setprio(0); } while (0)
#define PG8_WAIT_V(n) asm volatile("s_waitcnt vmcnt(" #n ")" ::: "memory")
#define PG8_WAIT_L(n) asm volatile("s_waitcnt lgkmcnt(" #n ")" ::: "memory")
#define PG8_BAR __builtin_amdgcn_s_barrier()
#define PG8_SCHED __builtin_amdgcn_sched_barrier(0)
    Unit cur, nxt; int ui = 0;
    if (!S.next(0, cur)) return;
    f32x4 acc[2][2][4][2];
#pragma unroll
    for (int a = 0; a < 2; ++a)
#pragma unroll
        for (int b = 0; b < 2; ++b)
#pragma unroll
            for (int m = 0; m < 4; ++m)
#pragma unroll
                for (int n = 0; n < 2; ++n) acc[a][b][m][n] = (f32x4){0.f, 0.f, 0.f, 0.f};
    bf16x8 At[4][2], B0[2][2], B1[2][2];
    const char* cA = (const char*)g.A + (size_t)cur.pm * tstep; const char* cB = (const char*)g.Bt + (size_t)cur.pn * tstep;
    S.a_ready(cur);
    if constexpr (SP2) {
        PG8_STAGE(PG8_SB(0, 0), cB, voffB); PG8_STAGE(PG8_SB(0, 1), cB + hstep, voffB); PG8_STAGE(PG8_SA(0, 0), cA, voffA); PG8_STAGE(PG8_SA(0, 1), cA + hstep, voffA);
        if (wr == 1) PG8_BAR;
        PG8_WAIT_V(2); PG8_BAR;
        PG8_STAGE(PG8_SB(1, 0), cB + kstep, voffB); PG8_STAGE(PG8_SA(1, 0), cA + kstep, voffA); PG8_STAGE(PG8_SB(1, 1), cB + hstep + kstep, voffB);
        PG8_WAIT_V(6); PG8_BAR;
    } else {
        PG8_STAGE(PG8_SB(0, 0), cB, voffB); PG8_STAGE(PG8_SA(0, 0), cA, voffA); PG8_STAGE(PG8_SB(0, 1), cB + hstep, voffB); PG8_STAGE(PG8_SA(0, 1), cA + hstep, voffA);
        if (wr == 1) PG8_BAR;
        PG8_WAIT_V(4); PG8_BAR;
        PG8_STAGE(PG8_SB(1, 0), cB + kstep, voffB); PG8_STAGE(PG8_SA(1, 0), cA + kstep, voffA); PG8_STAGE(PG8_SB(1, 1), cB + hstep + kstep, voffB);
        PG8_WAIT_V(6); PG8_BAR;
    }
    for (;;) {
        const bool has_next = S.next(ui + 1, nxt);
        const char* nA = has_next ? (const char*)g.A + (size_t)nxt.pm * tstep : cA; const char* nB = has_next ? (const char*)g.Bt + (size_t)nxt.pn * tstep : cB;
        for (int t = 0; t < nt; t += 2) {
            const bool last = (t == nt - 2);
            const char* a1 = cA + (size_t)(t + 1) * kstep;
            const char* a2 = last ? nA : cA + (size_t)(t + 2) * kstep; const char* b2 = last ? nB : cB + (size_t)(t + 2) * kstep;
            const char* a3 = a2 + kstep; const char* b3 = b2 + kstep;
            if (last && has_next) S.a_ready(nxt);
            if constexpr (SP2) {
            PG8_LDB(B0, 0, 0); PG8_LDB(B1, 0, 1); PG8_SCHED; PG8_LDA(At, 0, 0); PG8_STAGE(PG8_SA(1, 1), a1 + hstep, voffA);
            PG8_WAIT_V(8); PG8_WAIT_L(0); PG8_BAR; PG8_MMA(0, 0, At, B0); PG8_MMA(0, 1, At, B1); PG8_BAR; PG8_SCHED;
            PG8_LDA(At, 0, 1); PG8_STAGE(PG8_SB(0, 0), b2, voffB); PG8_STAGE(PG8_SB(0, 1), b2 + hstep, voffB); PG8_STAGE(PG8_SA(0, 0), a2, voffA);
            PG8_WAIT_V(8); PG8_WAIT_L(0); PG8_BAR; PG8_MMA(1, 0, At, B0); PG8_MMA(1, 1, At, B1); PG8_BAR; PG8_SCHED;
            PG8_LDB(B0, 1, 0); PG8_LDB(B1, 1, 1); PG8_SCHED; PG8_LDA(At, 1, 0); PG8_STAGE(PG8_SA(0, 1), a2 + hstep, voffA);
            PG8_WAIT_V(8); PG8_WAIT_L(0); PG8_BAR; PG8_MMA(0, 0, At, B0); PG8_MMA(0, 1, At, B1); PG8_BAR; PG8_SCHED;
            PG8_LDA(At, 1, 1); PG8_STAGE(PG8_SB(1, 0), b3, voffB); PG8_STAGE(PG8_SB(1, 1), b3 + hstep, voffB); PG8_STAGE(PG8_SA(1, 0), a3, voffA);
            PG8_WAIT_V(8); PG8_WAIT_L(0); PG8_BAR; PG8_MMA(1, 0, At, B0); PG8_MMA(1, 1, At, B1); PG8_BAR; PG8_SCHED;
            } else {
            PG8_LDB(B0, 0, 0); PG8_SCHED; PG8_LDA(At, 0, 0); PG8_STAGE(PG8_SA(1, 1), a1 + hstep, voffA);
            PG8_WAIT_L(8); PG8_BAR; PG8_WAIT_L(0); PG8_MMA(0, 0, At, B0); PG8_BAR; PG8_SCHED;
            PG8_LDB(B1, 0, 1); PG8_STAGE(PG8_SB(0, 0), b2, voffB);
            PG8_BAR; PG8_WAIT_L(0); PG8_MMA(0, 1, At, B1); PG8_BAR;
            PG8_LDA(At, 0, 1); PG8_STAGE(PG8_SA(0, 0), a2, voffA);
            PG8_BAR; PG8_WAIT_L(0); PG8_MMA(1, 0, At, B0); PG8_BAR; PG8_SCHED;
            PG8_STAGE(PG8_SB(0, 1), b2 + hstep, voffB);
            PG8_WAIT_V(6); PG8_BAR; PG8_MMA(1, 1, At, B1); PG8_BAR;
            PG8_LDB(B0, 1, 0); PG8_SCHED; PG8_LDA(At, 1, 0); PG8_STAGE(PG8_SA(0, 1), a2 + hstep, voffA);
            PG8_WAIT_L(8); PG8_BAR; PG8_WAIT_L(0); PG8_MMA(0, 0, At, B0); PG8_BAR; PG8_SCHED;
            PG8_LDB(B1, 1, 1); PG8_STAGE(PG8_SB(1, 0), b3, voffB);
            PG8_BAR; PG8_WAIT_L(0); PG8_MMA(0, 1, At, B1); PG8_BAR;
            PG8_LDA(At, 1, 1); PG8_STAGE(PG8_SA(1, 0), a3, voffA);
            PG8_BAR; PG8_WAIT_L(0); PG8_MMA(1, 0, At, B0); PG8_BAR; PG8_SCHED;
            PG8_STAGE(PG8_SB(1, 1), b3 + hstep, voffB);
            PG8_WAIT_V(6); PG8_BAR; PG8_MMA(1, 1, At, B1); PG8_BAR;
            }
        }
        if constexpr (ALIGN_EPI) { if (wr == 0) PG8_BAR; }
        if constexpr (!Epi::AFTER_DRAIN) { E(acc, cur, wr, wc, fr, fq); S.done(cur); }
        if (!has_next) break;
#pragma unroll
        for (int a = 0; a < 2; ++a)
#pragma unroll
            for (int b = 0; b < 2; ++b)
#pragma unroll
                for (int m = 0; m < 4; ++m)
#pragma unroll
                    for (int n = 0; n < 2; ++n) acc[a][b][m][n] = (f32x4){0.f, 0.f, 0.f, 0.f};
        cur = nxt; cA = nA; cB = nB; ++ui;
        if constexpr (ALIGN_EPI) { if (wr == 1) PG8_BAR; }
    }
    PG8_WAIT_V(0);
    if constexpr (!ALIGN_EPI) { if (wr == 0) PG8_BAR; }
    PG8_BAR;
    if constexpr (Epi::AFTER_DRAIN) { E.fused(acc, cur, wr, wc, fr, fq, lds, wid, lane); S.done(cur); }
#undef PG8_SA
#undef PG8_SB
#undef PG8_STAGE
#undef PG8_LDA
#undef PG8_LDB
#undef PG8_MMA
#undef PG8_WAIT_V
#undef PG8_WAIT_L
#undef PG8_BAR
#undef PG8_SCHED
}
}
#define LAS __attribute__((address_space(3)))
typedef unsigned short bf16;
typedef float f32x4 __attribute__((ext_vector_type(4)));
typedef short bf16x8 __attribute__((ext_vector_type(8)));
typedef unsigned v4u __attribute__((ext_vector_type(4)));
typedef unsigned v2u __attribute__((ext_vector_type(2)));

constexpr int NWAVES = 8, NT = NWAVES * 64;
constexpr int D = 1024, NP = 16384, NS = 512, M = NP + NS, FF = 4096, SEQ = 2048;
constexpr int GIN = 3088;
constexpr float ALPHA = 1.4142135623730951f, LN_EPS = 1e-5f, RMS_EPS = 1e-6f;
constexpr int LDS_BYTES = 147456, MISC_OFF = 131072 + 8192;
constexpr size_t O_Y = 0, O_GLAP = 17301504, O_GLAS = 18350080, O_CONVP = 35127296, O_CONVS = 35143680;
constexpr size_t MiB = 1u << 20;
constexpr size_t WS_WGIN = 1 * MiB, WS_WCIN = 7 * MiB, WS_WO = 13 * MiB, WS_WOUT = 15 * MiB, WS_WUP0 = 17 * MiB, WS_WUP1 = 25 * MiB, WS_WDN0 = 33 * MiB, WS_WDN1 = 41 * MiB;
constexpr size_t WS_R0 = 49 * MiB;
constexpr size_t WS_R1 = 82 * MiB;
constexpr size_t WS_QD = 115 * MiB, WS_KD = WS_QD + (size_t)M * 512 * 2, WS_KS = WS_KD + (size_t)M * 512 * 2, WS_V = WS_KS + (size_t)M * 512 * 2, WS_RS = WS_V + (size_t)M * 1024 * 2;
constexpr size_t WS_H = 115 * MiB;
static_assert(WS_RS + (size_t)M * 1024 * 2 <= 256 * MiB && WS_H + (size_t)M * FF * 2 <= 256 * MiB, "ws map");

__device__ __forceinline__ float bf2f(unsigned h) { return __uint_as_float(h << 16); }
__device__ __forceinline__ unsigned f2bf(float f) { unsigned u = __builtin_bit_cast(unsigned, f); return (u + 0x7fffu + ((u >> 16) & 1u)) >> 16; }
__device__ __forceinline__ unsigned pk2(float lo, float hi) { return f2bf(lo) | (f2bf(hi) << 16); }
__device__ __forceinline__ float wave_sum(float v) {
#pragma unroll
    for (int o = 1; o < 64; o <<= 1) v += __shfl_xor(v, o);
    return v;
}
#define LDS_WAIT() asm volatile("s_waitcnt lgkmcnt(0)" ::: "memory")

__device__ __forceinline__ void transpose_item(const float* W, int K, int N, int ld, bf16* WT, LAS float* scr, int item, int lane) {
    const int nblk = N / 32, kb = item / nblk, nb = item % nblk, k0 = 64 * kb, n0 = 32 * nb;
#pragma unroll 8
    for (int i = 0; i < 32; ++i) { const int kk = 2 * i + (lane >> 5); scr[kk * 33 + (lane & 31)] = W[(size_t)(k0 + kk) * ld + n0 + (lane & 31)]; }
    LDS_WAIT(); asm volatile("" ::: "memory");
    const int c = lane & 7;
#pragma unroll
    for (int j = 0; j < 4; ++j) { const int n = (lane >> 3) + 8 * j; const LAS float* s = scr + (8 * c) * 33 + n;
        v4u o; o.x = pk2(s[0 * 33], s[1 * 33]); o.y = pk2(s[2 * 33], s[3 * 33]); o.z = pk2(s[4 * 33], s[5 * 33]); o.w = pk2(s[6 * 33], s[7 * 33]);
        *(v4u*)(WT + (size_t)(n0 + n) * K + k0 + 8 * c) = o; }
    LDS_WAIT(); asm volatile("" ::: "memory");
}

template <bool OUT_F32>
__device__ __forceinline__ void ln_row(const float* zrow, const float* g, const float* bta, void* orow, int lane) {
    const f32x4* xr = (const f32x4*)zrow + lane;
    f32x4 v[4]; float s = 0.f;
#pragma unroll
    for (int j = 0; j < 4; ++j) { v[j] = xr[64 * j]; s += (v[j].x + v[j].y) + (v[j].z + v[j].w); }
    const float mean = wave_sum(s) * (1.f / D); float s2 = 0.f;
#pragma unroll
    for (int j = 0; j < 4; ++j) { v[j] = v[j] - mean; s2 += (v[j].x * v[j].x + v[j].y * v[j].y) + (v[j].z * v[j].z + v[j].w * v[j].w); }
    const float rstd = 1.f / sqrtf(wave_sum(s2) * (1.f / D) + LN_EPS);
#pragma unroll
    for (int j = 0; j < 4; ++j) { const f32x4 gg = ((const f32x4*)g)[lane + 64 * j], bb = ((const f32x4*)bta)[lane + 64 * j]; const f32x4 o = v[j] * rstd * gg + bb;
        if (OUT_F32) ((f32x4*)orow)[lane + 64 * j] = o;
        else { v2u w; w.x = pk2(o.x, o.y); w.y = pk2(o.z, o.w); ((v2u*)orow)[lane + 64 * j] = w; } }
}
__device__ __forceinline__ float logsig(float x) { return fminf(x, 0.f) - log1pf(expf(-fabsf(x))); }

__device__ __forceinline__ void gate_item(LAS unsigned char* lds, int item, const float* xp, const float* xs, const float* w_in, const float* w_up, const float* b_gate, float* Bc, int tid) {
    LAS float* Wgl = (LAS float*)lds;
    LAS float* gl = (LAS float*)(lds + 65536);
    const int R0 = item * 64; const bool samp = R0 >= NP;
    const float* xbase = samp ? xs + (size_t)(R0 - NP) * D : xp + (size_t)R0 * D;
    for (int e = tid; e < 1024 * 16; e += NT) Wgl[e] = w_in[(size_t)(e >> 4) * GIN + 3072 + (e & 15)];
    __syncthreads();
    {
        const int r = tid >> 3, t8 = tid & 7;
        f32x4 a0 = {0.f, 0.f, 0.f, 0.f}, a1 = a0, a2 = a0, a3 = a0;
        const float* xr = xbase + (size_t)r * D;
#pragma unroll
        for (int hb = 0; hb < 2; ++hb) {
            f32x4 xv[16];
#pragma unroll
            for (int it = 0; it < 16; ++it) xv[it] = *(const f32x4*)(xr + ((hb * 16 + it) * 8 + t8) * 4);
            __builtin_amdgcn_sched_barrier(0);
#pragma unroll
            for (int it = 0; it < 16; ++it) { const int k4 = ((hb * 16 + it) * 8 + t8) * 4;
#pragma unroll
                for (int kk = 0; kk < 4; ++kk) { const LAS f32x4* wr_ = (const LAS f32x4*)(Wgl + (k4 + kk) * 16); const float xe = xv[it][kk];
                    a0 += wr_[0] * xe; a1 += wr_[1] * xe; a2 += wr_[2] * xe; a3 += wr_[3] * xe; } }
        }
#pragma unroll
        for (int o = 1; o < 8; o <<= 1) {
#pragma unroll
            for (int e = 0; e < 4; ++e) { a0[e] += __shfl_xor(a0[e], o); a1[e] += __shfl_xor(a1[e], o); a2[e] += __shfl_xor(a2[e], o); a3[e] += __shfl_xor(a3[e], o); } }
        if (t8 == 0) { LAS f32x4* gp = (LAS f32x4*)(gl + r * 16); gp[0] = a0; gp[1] = a1; gp[2] = a2; gp[3] = a3; }
    }
    __syncthreads();
    {
        const int c = tid; float wu[16];
#pragma unroll
        for (int j = 0; j < 16; ++j) wu[j] = w_up[j * 512 + c];
        const float bg = b_gate[c]; float run = 0.f;
        for (int r = 0; r < 64; ++r) { const LAS f32x4* gp = (const LAS f32x4*)(gl + r * 16); float pre = bg;
#pragma unroll
            for (int q = 0; q < 4; ++q) { const f32x4 gv = gp[q]; pre += gv.x * wu[4 * q] + gv.y * wu[4 * q + 1] + gv.z * wu[4 * q + 2] + gv.w * wu[4 * q + 3]; }
            const float g = logsig(pre) * 0.0625f;
            if (samp && (r & 3) == 0) run = 0.f;
            run += g; Bc[(size_t)(R0 + r) * 512 + c] = run; }
    }
    __syncthreads();
}

#define MFMA16(a, b, c) __builtin_amdgcn_mfma_f32_16x16x32_bf16((a), (b), (c), 0, 0, 0)
__device__ __forceinline__ void gla_prompt_item(LAS unsigned char* lds, int item, const bf16* QD, const bf16* KD, const bf16* KS, const bf16* V, const float* Bc, bf16* OB, float* gla_p, int tid) {
    const int wid = __builtin_amdgcn_readfirstlane(tid >> 6), lane = tid & 63, l16 = lane & 15, quad = lane >> 4;
    const int s = item & 7, h = (item >> 3) & 3, b = item >> 5;
    LAS bf16* Vt = (LAS bf16*)lds;
    LAS bf16* KSt = (LAS bf16*)(lds + 4608);
    LAS bf16* Pb = (LAS bf16*)(lds + 23040);
    LAS bf16* St = (LAS bf16*)(lds + 32256);
    f32x4 S0 = {0.f, 0.f, 0.f, 0.f}, S1 = S0;
    const int ib = wid >> 1, jb0 = (wid & 1) * 2, vb = wid & 1;
    for (int n = 0; n < 32; ++n) {
        const size_t r0 = (size_t)b * SEQ + n * 64;
        { const int j = tid >> 3, c4 = (tid & 7) * 4;
          const v2u vv = *(const v2u*)(V + (r0 + j) * 1024 + h * 256 + s * 32 + c4);
          Vt[(c4 + 0) * 72 + j] = (bf16)(vv.x & 0xffffu); Vt[(c4 + 1) * 72 + j] = (bf16)(vv.x >> 16); Vt[(c4 + 2) * 72 + j] = (bf16)(vv.y & 0xffffu); Vt[(c4 + 3) * 72 + j] = (bf16)(vv.y >> 16);
          const int c16 = (tid & 7) * 16;
          const v4u k0 = *(const v4u*)(KS + (r0 + j) * 512 + h * 128 + c16), k1 = *(const v4u*)(KS + (r0 + j) * 512 + h * 128 + c16 + 8);
#pragma unroll
          for (int e = 0; e < 4; ++e) { KSt[(c16 + 2 * e) * 72 + j] = (bf16)(k0[e] & 0xffffu); KSt[(c16 + 2 * e + 1) * 72 + j] = (bf16)(k0[e] >> 16);
                                        KSt[(c16 + 8 + 2 * e) * 72 + j] = (bf16)(k1[e] & 0xffffu); KSt[(c16 + 8 + 2 * e + 1) * 72 + j] = (bf16)(k1[e] >> 16); }
          v2u w; w.x = pk2(S0[0], S0[1]); w.y = pk2(S0[2], S0[3]); *(LAS v2u*)(St + l16 * 136 + 16 * wid + quad * 4) = w;
          w.x = pk2(S1[0], S1[1]); w.y = pk2(S1[2], S1[3]); *(LAS v2u*)(St + (16 + l16) * 136 + 16 * wid + quad * 4) = w; }
        bf16x8 qa[4];
        { const bf16* qp = QD + (r0 + ib * 16 + l16) * 512 + h * 128 + quad * 8;
#pragma unroll
          for (int kk = 0; kk < 4; ++kk) qa[kk] = *(const bf16x8*)(qp + kk * 32);
#pragma unroll
          for (int jj = 0; jj < 2; ++jj) { const int jb = jb0 + jj; f32x4 p = {0.f, 0.f, 0.f, 0.f};
              const bf16* kp = KD + (r0 + jb * 16 + l16) * 512 + h * 128 + quad * 8;
#pragma unroll
              for (int kk = 0; kk < 4; ++kk) { const bf16x8 kb = *(const bf16x8*)(kp + kk * 32); p = MFMA16(qa[kk], kb, p); }
#pragma unroll
              for (int t = 0; t < 4; ++t) { const int i = ib * 16 + quad * 4 + t, jcol = jb * 16 + l16; Pb[i * 72 + jcol] = (bf16)f2bf(jcol <= i ? p[t] : 0.f); } } }
        __syncthreads();
        { f32x4 o = {0.f, 0.f, 0.f, 0.f};
#pragma unroll
          for (int kk = 0; kk < 2; ++kk) { const bf16x8 va = *(const LAS bf16x8*)(Vt + (vb * 16 + l16) * 72 + kk * 32 + quad * 8), pbv = *(const LAS bf16x8*)(Pb + (ib * 16 + l16) * 72 + kk * 32 + quad * 8); o = MFMA16(va, pbv, o); }
#pragma unroll
          for (int kk = 0; kk < 4; ++kk) { const bf16x8 sa = *(const LAS bf16x8*)(St + (vb * 16 + l16) * 136 + kk * 32 + quad * 8); o = MFMA16(sa, qa[kk], o); }
          v2u w; w.x = pk2(o[0], o[1]); w.y = pk2(o[2], o[3]);
          *(v2u*)(OB + (r0 + ib * 16 + l16) * 1024 + h * 256 + s * 32 + vb * 16 + quad * 4) = w; }
        { const f32x4 bl = *(const f32x4*)(Bc + (r0 + 63) * 512 + h * 128 + 16 * wid + quad * 4);
#pragma unroll
          for (int t = 0; t < 4; ++t) { const float dc = __expf(bl[t]); S0[t] *= dc; S1[t] *= dc; }
#pragma unroll
          for (int kk = 0; kk < 2; ++kk) { const bf16x8 ka = *(const LAS bf16x8*)(KSt + (16 * wid + l16) * 72 + kk * 32 + quad * 8);
              const bf16x8 v0 = *(const LAS bf16x8*)(Vt + l16 * 72 + kk * 32 + quad * 8), v1 = *(const LAS bf16x8*)(Vt + (16 + l16) * 72 + kk * 32 + quad * 8);
              S0 = MFMA16(ka, v0, S0); S1 = MFMA16(ka, v1, S1); } }
        __syncthreads();
    }
    float* sp = gla_p + ((size_t)(b * 4 + h) * 128 + 16 * wid + quad * 4) * 256 + s * 32 + l16;
#pragma unroll
    for (int t = 0; t < 4; ++t) { sp[(size_t)t * 256] = S0[t]; sp[(size_t)t * 256 + 16] = S1[t]; }
}

__device__ __forceinline__ void gla_sample_item(LAS unsigned char* lds, int item, const bf16* QD, const bf16* KD, const bf16* KS, const bf16* V, const float* Bc, const float* st_in, bf16* OB, float* gla_s, int tid) {
    LAS float* qf = (LAS float*)lds;
    LAS float* kdf = qf + 512;
    LAS float* ksf = kdf + 512;
    LAS float* decf = ksf + 512;
    LAS float* Pm = decf + 128;
    LAS float* vf = Pm + 16;
    LAS float* part = vf + 1024;
    const int b = item >> 2, h = item & 3; const size_t r0 = (size_t)NP + b * 4;
    { const int i = tid >> 7, d = tid & 127; const size_t o = (r0 + i) * 512 + h * 128 + d;
      qf[tid] = bf2f(QD[o]); kdf[tid] = bf2f(KD[o]); ksf[tid] = bf2f(KS[o]);
      if (tid < 128) decf[tid] = __expf(Bc[(r0 + 3) * 512 + h * 128 + tid]);
#pragma unroll
      for (int q = 0; q < 2; ++q) { const int e = tid + q * 512, j = e >> 8, v = e & 255; vf[e] = bf2f(V[(r0 + j) * 1024 + h * 256 + v]); } }
    __syncthreads();
    if (tid < 16) { const int i = tid >> 2, j = tid & 3; float p = 0.f;
        if (j <= i) for (int d = 0; d < 128; ++d) p += qf[i * 128 + d] * kdf[j * 128 + d];
        Pm[tid] = p; }
    {
        const int v4 = (tid & 63) * 4, g = tid >> 6;
        f32x4 vv[4], pt[4];
#pragma unroll
        for (int j = 0; j < 4; ++j) { vv[j] = *(const LAS f32x4*)(vf + j * 256 + v4); pt[j] = (f32x4){0.f, 0.f, 0.f, 0.f}; }
        const size_t sbase = ((size_t)(b * 4 + h) * 128 + g * 16) * 256 + v4;
#pragma unroll 4
        for (int dd = 0; dd < 16; ++dd) { const int d = g * 16 + dd; const f32x4 s0 = *(const f32x4*)(st_in + sbase + (size_t)dd * 256);
            f32x4 sn = s0 * decf[d];
#pragma unroll
            for (int j = 0; j < 4; ++j) { pt[j] += s0 * qf[j * 128 + d]; sn += vv[j] * ksf[j * 128 + d]; }
            *(f32x4*)(gla_s + sbase + (size_t)dd * 256) = sn; }
#pragma unroll
        for (int j = 0; j < 4; ++j) *(LAS f32x4*)(part + (g * 4 + j) * 256 + v4) = pt[j];
    }
    __syncthreads();
    { const int e = tid * 2, i = e >> 8, v = e & 255; float o0 = 0.f, o1 = 0.f;
#pragma unroll
      for (int g = 0; g < 8; ++g) { o0 += part[(g * 4 + i) * 256 + v]; o1 += part[(g * 4 + i) * 256 + v + 1]; }
#pragma unroll
      for (int j = 0; j < 4; ++j) { const float p = (j <= i) ? Pm[i * 4 + j] : 0.f; o0 += p * vf[j * 256 + v]; o1 += p * vf[j * 256 + v + 1]; }
      *(unsigned*)(OB + (r0 + i) * 1024 + h * 256 + v) = pk2(o0, o1); }
    __syncthreads();
}

__device__ __forceinline__ void gnorm_row(const bf16* orow, const bf16* rsrow, const float* ng, bf16* arow, int lane) {
    const v4u o0 = *(const v4u*)(orow + lane * 16), o1 = *(const v4u*)(orow + lane * 16 + 8);
    const v4u r0 = *(const v4u*)(rsrow + lane * 16), r1 = *(const v4u*)(rsrow + lane * 16 + 8);
    float ov[16], rv[16];
#pragma unroll
    for (int e = 0; e < 4; ++e) { ov[2 * e] = bf2f(o0[e] & 0xffffu); ov[2 * e + 1] = bf2f(o0[e] >> 16); ov[8 + 2 * e] = bf2f(o1[e] & 0xffffu); ov[8 + 2 * e + 1] = bf2f(o1[e] >> 16);
                                  rv[2 * e] = bf2f(r0[e] & 0xffffu); rv[2 * e + 1] = bf2f(r0[e] >> 16); rv[8 + 2 * e] = bf2f(r1[e] & 0xffffu); rv[8 + 2 * e + 1] = bf2f(r1[e] >> 16); }
    float ss = 0.f;
#pragma unroll
    for (int e = 0; e < 16; ++e) ss += ov[e] * ov[e];
#pragma unroll
    for (int o = 1; o < 16; o <<= 1) ss += __shfl_xor(ss, o);
    const float rs = 1.f / sqrtf(ss * (1.f / 256.f) + RMS_EPS);
    v4u w0, w1;
#pragma unroll
    for (int e = 0; e < 4; ++e) { const f32x4 g0 = *(const f32x4*)(ng + lane * 16 + 4 * e);
        const float a = ov[4 * e] * rs * g0.x * rv[4 * e], b = ov[4 * e + 1] * rs * g0.y * rv[4 * e + 1], c = ov[4 * e + 2] * rs * g0.z * rv[4 * e + 2], d = ov[4 * e + 3] * rs * g0.w * rv[4 * e + 3];
        if (e < 2) { w0[2 * e] = pk2(a, b); w0[2 * e + 1] = pk2(c, d); } else { w1[2 * (e - 2)] = pk2(a, b); w1[2 * (e - 2) + 1] = pk2(c, d); } }
    *(v4u*)(arow + lane * 16) = w0; *(v4u*)(arow + lane * 16 + 8) = w1;
}

__device__ __forceinline__ void load16(const bf16* p, float (&v)[16]) {
    const v4u a = *(const v4u*)p, b = *(const v4u*)(p + 8);
#pragma unroll
    for (int e = 0; e < 4; ++e) { v[2 * e] = bf2f(a[e] & 0xffffu); v[2 * e + 1] = bf2f(a[e] >> 16); v[8 + 2 * e] = bf2f(b[e] & 0xffffu); v[8 + 2 * e + 1] = bf2f(b[e] >> 16); }
}
__device__ __forceinline__ void loadf16(const float* p, float (&v)[16]) {
#pragma unroll
    for (int e = 0; e < 4; ++e) { const f32x4 a = *(const f32x4*)(p + 4 * e); v[4 * e] = a.x; v[4 * e + 1] = a.y; v[4 * e + 2] = a.z; v[4 * e + 3] = a.w; }
}
__device__ __forceinline__ void conv_row(int row, const bf16* BCH, const float* wconv, const float* st_conv, bf16* A3, float* out, int lane) {
    const int c0 = lane * 16;
    int t, T; size_t rb; const float* hist = nullptr; float* so;
    if (row < NP) { t = row & (SEQ - 1); T = SEQ; rb = (size_t)row - t; so = out + O_CONVP + (size_t)(row >> 11) * 2 * D; }
    else { const int q = row - NP; t = q & 3; T = 4; rb = (size_t)row - t; hist = st_conv + (size_t)(q >> 2) * 2 * D; so = out + O_CONVS + (size_t)(q >> 2) * 2 * D; }
    float bgv[16], u0[16], u1[16], u2[16], a[16], b[16];
    load16(BCH + (size_t)row * 3072 + c0, bgv);
    load16(BCH + (size_t)row * 3072 + 1024 + c0, a); load16(BCH + (size_t)row * 3072 + 2048 + c0, b);
#pragma unroll
    for (int e = 0; e < 16; ++e) u2[e] = a[e] * b[e];
    if (t >= 1) { load16(BCH + (rb + t - 1) * 3072 + 1024 + c0, a); load16(BCH + (rb + t - 1) * 3072 + 2048 + c0, b);
#pragma unroll
        for (int e = 0; e < 16; ++e) u1[e] = a[e] * b[e]; }
    else if (hist) loadf16(hist + D + c0, u1);
    else {
#pragma unroll
        for (int e = 0; e < 16; ++e) u1[e] = 0.f; }
    if (t >= 2) { load16(BCH + (rb + t - 2) * 3072 + 1024 + c0, a); load16(BCH + (rb + t - 2) * 3072 + 2048 + c0, b);
#pragma unroll
        for (int e = 0; e < 16; ++e) u0[e] = a[e] * b[e]; }
    else if (hist) loadf16(hist + (size_t)t * D + c0, u0);
    else {
#pragma unroll
        for (int e = 0; e < 16; ++e) u0[e] = 0.f; }
    float w0[16], w1[16], w2[16];
    loadf16(wconv + c0, w0); loadf16(wconv + D + c0, w1); loadf16(wconv + 2 * D + c0, w2);
    v4u o0, o1;
#pragma unroll
    for (int e = 0; e < 4; ++e) {
        float r[4];
#pragma unroll
        for (int q = 0; q < 4; ++q) { const int i = 4 * e + q; r[q] = bgv[i] * (u0[i] * w0[i] + u1[i] * w1[i] + u2[i] * w2[i]); }
        if (e < 2) { o0[2 * e] = pk2(r[0], r[1]); o0[2 * e + 1] = pk2(r[2], r[3]); } else { o1[2 * (e - 2)] = pk2(r[0], r[1]); o1[2 * (e - 2) + 1] = pk2(r[2], r[3]); } }
    *(v4u*)(A3 + (size_t)row * D + c0) = o0; *(v4u*)(A3 + (size_t)row * D + c0 + 8) = o1;
    if (t >= T - 2) { float* sp = so + (size_t)(t - (T - 2)) * D + c0;
#pragma unroll
        for (int e = 0; e < 4; ++e) *(f32x4*)(sp + 4 * e) = (f32x4){u2[4 * e], u2[4 * e + 1], u2[4 * e + 2], u2[4 * e + 3]}; }
}

#define XB_TMO      128
#define XB_XCNT(j)  (256  + 64 * (j))
#define XB_XSUB(j)  (1280 + 64 * (j))
#define XB_XGEN(j)  (2304 + 64 * (j))
#define XB_TOP      3328
#define XB_TOPGEN   3392
#define XCD_BAR_WORDS 3456
#define XB_SPIN_CAP (1u << 18)

__device__ __forceinline__ unsigned xb_ld(unsigned* p)              { return __hip_atomic_load(p, __ATOMIC_RELAXED, __HIP_MEMORY_SCOPE_AGENT); }
__device__ __forceinline__ unsigned xb_add(unsigned* p, unsigned v) { return __hip_atomic_fetch_add(p, v, __ATOMIC_RELAXED, __HIP_MEMORY_SCOPE_AGENT); }
__device__ __forceinline__ unsigned xb_xcc_id() { return (unsigned)__builtin_amdgcn_s_getreg((3 << 11) | 20) & 0xFu; }
#define XB_SPIN(cond, bar) do { unsigned _sp = 0; while (cond) { __builtin_amdgcn_s_sleep(1); \
    if ((++_sp & 255u) == 0u) { if (xb_ld(&(bar)[XB_TMO])) break; if (_sp > XB_SPIN_CAP) { atomicAdd(&(bar)[XB_TMO], 1u); break; } } } } while (0)

struct XcdBarrier {
    unsigned* bar; unsigned x;
    volatile LAS unsigned* st;
};

__device__ __forceinline__ XcdBarrier xcd_barrier_post(unsigned* bar, volatile LAS unsigned* st) {
    XcdBarrier b; b.bar = bar; b.x = xb_xcc_id(); b.st = st;
    if (threadIdx.x == 0) (void)xb_add(&bar[XB_XCNT(b.x)], 1u);
    return b;
}
__device__ __forceinline__ void xcd_barrier_complete(unsigned* bar, unsigned x, unsigned& nloc, unsigned& nx) {
    const unsigned G = gridDim.x * gridDim.y * gridDim.z;
    unsigned sum, cnt, mine, sp = 0u;
    for (;;) {
        sum = 0u; cnt = 0u; mine = 0u;
#pragma unroll
        for (unsigned j = 0; j < 16; ++j) { const unsigned c = xb_ld(&bar[XB_XCNT(j)]); sum += c; cnt += (c > 0u) ? 1u : 0u; mine = (j == x) ? c : mine; }
        if (sum == G) break;
        __builtin_amdgcn_s_sleep(1);
        if ((++sp & 255u) == 0u) { if (xb_ld(&bar[XB_TMO])) break; if (sp > XB_SPIN_CAP) { atomicAdd(&bar[XB_TMO], 1u); break; } }
    }
    nloc = mine > 0u ? mine : 1u; nx = cnt > 0u ? cnt : 1u;
}

__device__ __forceinline__ void xcd_barrier(const XcdBarrier& b) {
    asm volatile("s_waitcnt vmcnt(0)" ::: "memory");
    __syncthreads();
    if (threadIdx.x == 0) {
        unsigned* bar = b.bar;
        __builtin_amdgcn_s_waitcnt(0);
        unsigned nloc = b.st[0], nx = b.st[1];
        if (nloc == 0u) { xcd_barrier_complete(bar, b.x, nloc, nx); b.st[0] = nloc; b.st[1] = nx; }
        const unsigned old = xb_add(&bar[XB_XSUB(b.x)], 1u);
        const unsigned gen = old / nloc;
        if (old + 1u == (gen + 1u) * nloc) {
            __builtin_amdgcn_fence(__ATOMIC_RELEASE, "agent");
            asm volatile("s_waitcnt vmcnt(0)" ::: "memory");
            const unsigned og = xb_add(&bar[XB_TOP], 1u);
            const unsigned tg = og / nx;
            if (og + 1u == (tg + 1u) * nx) xb_add(&bar[XB_TOPGEN], 1u);
            else XB_SPIN(xb_ld(&bar[XB_TOPGEN]) == tg, bar);
            __builtin_amdgcn_fence(__ATOMIC_ACQUIRE, "agent");
            xb_add(&bar[XB_XGEN(b.x)], 1u);
            asm volatile("s_waitcnt vmcnt(0)" ::: "memory");
        } else {
            XB_SPIN(xb_ld(&bar[XB_XGEN(b.x)]) == gen, bar);
            __builtin_amdgcn_fence(__ATOMIC_ACQUIRE, "agent");
            asm volatile("s_waitcnt vmcnt(0)" ::: "memory");
        }
    }
    __syncthreads();
}


constexpr size_t WS_ZP = 247 * MiB;
template <class Epi>
__device__ __forceinline__ void skinny_unit(const bf16* A, const bf16* Bt, int K, int k0, int k1, int tm, int tn, const Epi& E, int tid) {
    const int wid = __builtin_amdgcn_readfirstlane(tid >> 6), lane = tid & 63, l16 = lane & 15, quad = lane >> 4, wr = wid >> 2, wc = wid & 3;
    const bf16* ap = A + (size_t)(tm * 64 + wr * 32 + l16) * K + quad * 8;
    const bf16* bp = Bt + (size_t)(tn * 128 + wc * 32 + l16) * K + quad * 8;
    const size_t r16 = (size_t)16 * K;
    f32x4 acc[2][2];
#pragma unroll
    for (int mi = 0; mi < 2; ++mi) { acc[mi][0] = (f32x4){0.f, 0.f, 0.f, 0.f}; acc[mi][1] = (f32x4){0.f, 0.f, 0.f, 0.f}; }
    for (int k = k0; k < k1; k += 256) {
        bf16x8 a[8][2], b[8][2];
#pragma unroll
        for (int q = 0; q < 8; ++q) { a[q][0] = *(const bf16x8*)(ap + k + q * 32); a[q][1] = *(const bf16x8*)(ap + r16 + k + q * 32);
                                      b[q][0] = *(const bf16x8*)(bp + k + q * 32); b[q][1] = *(const bf16x8*)(bp + r16 + k + q * 32); }
        __builtin_amdgcn_sched_barrier(0);
#pragma unroll
        for (int q = 0; q < 8; ++q)
#pragma unroll
            for (int mi = 0; mi < 2; ++mi)
#pragma unroll
                for (int ni = 0; ni < 2; ++ni) acc[mi][ni] = MFMA16(b[q][ni], a[q][mi], acc[mi][ni]);
        __builtin_amdgcn_sched_barrier(0);
    }
#pragma unroll
    for (int mi = 0; mi < 2; ++mi)
#pragma unroll
        for (int ni = 0; ni < 2; ++ni) E(tm * 64 + wr * 32 + mi * 16 + l16, tn * 128 + wc * 32 + ni * 16 + quad * 4, acc[mi][ni]);
}
template <int ACT> struct SkStore { bf16* O; int ldc;
    __device__ __forceinline__ void operator()(int row, int col, f32x4 v) const {
        if (ACT == 1) {
#pragma unroll
            for (int e = 0; e < 4; ++e) { const float a = fmaxf(v[e], 0.f); v[e] = a * a; } }
        v2u w; w.x = pk2(v[0], v[1]); w.y = pk2(v[2], v[3]); *(v2u*)(O + (size_t)(NP + row) * ldc + col) = w; } };
struct SkPartial { float* ZP;
    __device__ __forceinline__ void operator()(int row, int col, f32x4 v) const { *(f32x4*)(ZP + (size_t)row * D + col) = v; } };
struct SkGlaIn { bf16 *QD, *KD, *KS, *V, *RS; const float* Bc;
    __device__ __forceinline__ void operator()(int row, int col, f32x4 v) const {
        const size_t g = (size_t)NP + row; v2u w;
        if (col < 1024) { const int cl = col & 511; const f32x4 b0 = *(const f32x4*)(Bc + g * 512 + cl);
            if (col < 512) {
#pragma unroll
                for (int e = 0; e < 4; ++e) v[e] = v[e] * 0.08838834764831845f * __expf(b0[e]);
                w.x = pk2(v[0], v[1]); w.y = pk2(v[2], v[3]); *(v2u*)(QD + g * 512 + cl) = w;
            } else { const f32x4 l0 = *(const f32x4*)(Bc + (g | 3) * 512 + cl); f32x4 sv;
#pragma unroll
                for (int e = 0; e < 4; ++e) { sv[e] = v[e] * __expf(l0[e] - b0[e]); v[e] = v[e] * __expf(-b0[e]); }
                w.x = pk2(v[0], v[1]); w.y = pk2(v[2], v[3]); *(v2u*)(KD + g * 512 + cl) = w;
                w.x = pk2(sv[0], sv[1]); w.y = pk2(sv[2], sv[3]); *(v2u*)(KS + g * 512 + cl) = w; }
        } else if (col < 2048) { w.x = pk2(v[0], v[1]); w.y = pk2(v[2], v[3]); *(v2u*)(V + g * 1024 + (col - 1024)) = w; }
        else {
#pragma unroll
            for (int e = 0; e < 4; ++e) v[e] = v[e] / (1.f + __expf(-v[e]));
            w.x = pk2(v[0], v[1]); w.y = pk2(v[2], v[3]); *(v2u*)(RS + g * 1024 + (col - 2048)) = w; } } };
template <class Epi>
__device__ __forceinline__ void skinny_phase(const bf16* A, const bf16* Bt, int N, int K, const Epi& E, int bx, int G, int tid) {
    const int ntn = N / 128, nu = 8 * ntn;
    for (int u = bx; u < nu; u += G) skinny_unit(A, Bt, K, 0, K, u / ntn, u % ntn, E, tid);
}
__device__ __forceinline__ void skinny_phase_split(const bf16* A, const bf16* Bt, int K, float* ZP, int bx, int G, int tid) {
    const int nu = 8 * 8 * 4, kq = K / 4;
    for (int u = bx; u < nu; u += G) { const int sp = u & 3, t = u >> 2; SkPartial E{ZP + (size_t)sp * NS * D}; skinny_unit(A, Bt, K, sp * kq, (sp + 1) * kq, t >> 3, t & 7, E, tid); }
}
template <bool OUT_F32, bool RES_F32>
__device__ __forceinline__ void ln_row_sample(const float* ZP, int rs, const void* res, const float* g, const float* bta, void* orow, int lane) {
    f32x4 v[4]; float s = 0.f;
#pragma unroll
    for (int j = 0; j < 4; ++j) { const int c4 = lane + 64 * j; f32x4 r;
        if (RES_F32) r = ((const f32x4*)res)[c4];
        else { const v2u w = ((const v2u*)res)[c4]; r = (f32x4){bf2f(w.x & 0xffffu), bf2f(w.x >> 16), bf2f(w.y & 0xffffu), bf2f(w.y >> 16)}; }
        const f32x4* zp = (const f32x4*)(ZP + (size_t)rs * D) + c4;
        v[j] = r * ALPHA + ((zp[0] + zp[(size_t)NS * D / 4]) + (zp[(size_t)2 * NS * D / 4] + zp[(size_t)3 * NS * D / 4]));
        s += (v[j].x + v[j].y) + (v[j].z + v[j].w); }
    const float mean = wave_sum(s) * (1.f / D); float s2 = 0.f;
#pragma unroll
    for (int j = 0; j < 4; ++j) { v[j] = v[j] - mean; s2 += (v[j].x * v[j].x + v[j].y * v[j].y) + (v[j].z * v[j].z + v[j].w * v[j].w); }
    const float rstd = 1.f / sqrtf(wave_sum(s2) * (1.f / D) + LN_EPS);
#pragma unroll
    for (int j = 0; j < 4; ++j) { const f32x4 gg = ((const f32x4*)g)[lane + 64 * j], bb = ((const f32x4*)bta)[lane + 64 * j]; const f32x4 o = v[j] * rstd * gg + bb;
        if (OUT_F32) ((f32x4*)orow)[lane + 64 * j] = o;
        else { v2u w; w.x = pk2(o.x, o.y); w.y = pk2(o.z, o.w); ((v2u*)orow)[lane + 64 * j] = w; } }
}

struct Args { const float* in[18]; float* out; unsigned char* ws; };

__global__ void __launch_bounds__(NT, 2) mega_fwd(Args args) {
    extern __shared__ __attribute__((aligned(16))) unsigned char lds_raw[];
    LAS unsigned char* lds = (LAS unsigned char*)lds_raw;
    cg::grid_group grid = cg::this_grid();
    const int tid = threadIdx.x, lane = tid & 63, wave = __builtin_amdgcn_readfirstlane(tid >> 6);
    const int G = gridDim.x, bx = blockIdx.x;
    const int gw = bx * NWAVES + wave, NGW = G * NWAVES;
    unsigned char* ws = args.ws; float* out = args.out;
    const float *x_p = args.in[0], *x_s = args.in[1], *st_gla = args.in[2], *st_conv = args.in[3], *gla_w_in = args.in[4], *gla_w_up = args.in[5], *gla_bg = args.in[6], *gla_ng = args.in[7],
                *gla_w_o = args.in[8], *conv_w_in = args.in[9], *conv_w_conv = args.in[10], *conv_w_out = args.in[11], *mlp_up = args.in[12], *mlp_dn = args.in[13],
                *ln1_g = args.in[14], *ln1_b = args.in[15], *ln2_g = args.in[16], *ln2_b = args.in[17];
    bf16 *Wgin = (bf16*)(ws + WS_WGIN), *Wcin = (bf16*)(ws + WS_WCIN), *Wo = (bf16*)(ws + WS_WO), *Wout = (bf16*)(ws + WS_WOUT);
    bf16 *Wup0 = (bf16*)(ws + WS_WUP0), *Wup1 = (bf16*)(ws + WS_WUP1), *Wdn0 = (bf16*)(ws + WS_WDN0), *Wdn1 = (bf16*)(ws + WS_WDN1);
    bf16 *R0 = (bf16*)(ws + WS_R0), *R1 = (bf16*)(ws + WS_R1);
    float* Bc = (float*)(ws + WS_R1);
    bf16 *QD = (bf16*)(ws + WS_QD), *KD = (bf16*)(ws + WS_KD), *KS = (bf16*)(ws + WS_KS), *Vb = (bf16*)(ws + WS_V), *RS = (bf16*)(ws + WS_RS), *H = (bf16*)(ws + WS_H);
    float* Z = out + O_Y; float* ZP = (float*)(ws + WS_ZP);
    volatile LAS unsigned* MISC = (volatile LAS unsigned*)(lds + MISC_OFF);
    if (tid < 32) MISC[tid] = 0u;
    unsigned* barw = (unsigned*)ws;
    if (bx == 0) for (int u = tid; u < XCD_BAR_WORDS; u += NT) __hip_atomic_store(barw + u, 0u, __ATOMIC_RELAXED, __HIP_MEMORY_SCOPE_AGENT);
    __syncthreads();

    {
        LAS float* scr = (LAS float*)(lds + wave * 16384);
        constexpr int I_GIN = (D / 64) * (3072 / 32), I_SQ = (D / 64) * (D / 32), I_UP = (D / 64) * (FF / 32), I_DN = (FF / 64) * (D / 32);
        constexpr int NITEMS = 2 * I_GIN + 2 * I_SQ + 2 * I_UP + 2 * I_DN;
        for (int it = gw; it < NITEMS; it += NGW) {
            int r = it;
            if (r < I_GIN) { transpose_item(gla_w_in, D, 3072, GIN, Wgin, scr, r, lane); continue; } r -= I_GIN;
            if (r < I_GIN) { transpose_item(conv_w_in, D, 3072, 3072, Wcin, scr, r, lane); continue; } r -= I_GIN;
            if (r < I_SQ) { transpose_item(gla_w_o, D, D, D, Wo, scr, r, lane); continue; } r -= I_SQ;
            if (r < I_SQ) { transpose_item(conv_w_out, D, D, D, Wout, scr, r, lane); continue; } r -= I_SQ;
            if (r < I_UP) { transpose_item(mlp_up, D, FF, FF, Wup0, scr, r, lane); continue; } r -= I_UP;
            if (r < I_UP) { transpose_item(mlp_up + (size_t)D * FF, D, FF, FF, Wup1, scr, r, lane); continue; } r -= I_UP;
            if (r < I_DN) { transpose_item(mlp_dn, FF, D, D, Wdn0, scr, r, lane); continue; } r -= I_DN;
            transpose_item(mlp_dn + (size_t)D * FF, FF, D, D, Wdn1, scr, r, lane);
        }
        for (int m = gw; m < M; m += NGW) {
            const float* xr = (m < NP) ? x_p + (size_t)m * D : x_s + (size_t)(m - NP) * D;
#pragma unroll
            for (int j = 0; j < 4; ++j) { const f32x4 v = ((const f32x4*)xr)[lane + 64 * j]; v2u w; w.x = pk2(v.x, v.y); w.y = pk2(v.z, v.w); ((v2u*)(R0 + (size_t)m * D))[lane + 64 * j] = w; }
        }
        __syncthreads();
        for (int it = bx; it < M / 64; it += G) gate_item(lds, it, x_p, x_s, gla_w_in, gla_w_up, gla_bg, Bc, tid);
    }
    grid.sync();
    const XcdBarrier xbar = xcd_barrier_post(barw, MISC + 8);
    skinny_phase(R0 + (size_t)NP * D, Wgin, 3072, D, SkGlaIn{QD, KD, KS, Vb, RS, Bc}, bx, G, tid);
    { pg8::Gemm g{R0, Wgin, NP, 3072, D}; pg8::StaticOrder S; S.init(NP, 3072, G, bx);
      pg8::EpiGlaIn E{QD, KD, KS, Vb, RS, Bc};
      pg8::gemm_phase<pg8::EpiGlaIn, pg8::StaticOrder, true, true>(lds, g, S, E); }
    xcd_barrier(xbar);
    {
        for (int it = bx; it < 256; it += G) gla_prompt_item(lds, it, QD, KD, KS, Vb, Bc, R0, out + O_GLAP, tid);
        for (int it = bx; it < 512; it += G) gla_sample_item(lds, it, QD, KD, KS, Vb, Bc, st_gla, R0, out + O_GLAS, tid);
    }
    xcd_barrier(xbar);
    for (int m = gw; m < M; m += NGW) gnorm_row(R0 + (size_t)m * D, RS + (size_t)m * D, gla_ng, R1 + (size_t)m * D, lane);
    xcd_barrier(xbar);
    skinny_phase_split(R1 + (size_t)NP * D, Wo, D, ZP, bx, G, tid);
    { pg8::Gemm g{R1, Wo, NP, D, D}; pg8::StaticOrder S; S.init(NP, D, G, bx);
      pg8::EpiResid E{Z, x_p, x_s, nullptr, ALPHA};
      pg8::gemm_phase<pg8::EpiResid, pg8::StaticOrder, true, true>(lds, g, S, E); }
    xcd_barrier(xbar);
    for (int m = gw; m < M; m += NGW) { if (m < NP) ln_row<false>(Z + (size_t)m * D, ln1_g, ln1_b, R0 + (size_t)m * D, lane);
        else ln_row_sample<false, true>(ZP, m - NP, x_s + (size_t)(m - NP) * D, ln1_g, ln1_b, R0 + (size_t)m * D, lane); }
    xcd_barrier(xbar);
    skinny_phase(R0 + (size_t)NP * D, Wup0, FF, D, SkStore<1>{H, FF}, bx, G, tid);
    { pg8::Gemm g{R0, Wup0, NP, FF, D}; pg8::StaticOrder S; S.init(NP, FF, G, bx);
      pg8::EpiStore<1> E{H, FF};
      pg8::gemm_phase<pg8::EpiStore<1>, pg8::StaticOrder, true, true>(lds, g, S, E); }
    xcd_barrier(xbar);
    skinny_phase_split(H + (size_t)NP * FF, Wdn0, FF, ZP, bx, G, tid);
    { pg8::Gemm g{H, Wdn0, NP, D, FF}; pg8::StaticOrder S; S.init(NP, D, G, bx);
      pg8::EpiResid E{Z, nullptr, nullptr, R0, ALPHA};
      pg8::gemm_phase<pg8::EpiResid, pg8::StaticOrder, true, true>(lds, g, S, E); }
    xcd_barrier(xbar);
    for (int m = gw; m < M; m += NGW) { if (m < NP) ln_row<false>(Z + (size_t)m * D, ln2_g, ln2_b, R0 + (size_t)m * D, lane);
        else ln_row_sample<false, false>(ZP, m - NP, R0 + (size_t)m * D, ln2_g, ln2_b, R0 + (size_t)m * D, lane); }
    xcd_barrier(xbar);
    skinny_phase(R0 + (size_t)NP * D, Wcin, 3072, D, SkStore<0>{H, 3072}, bx, G, tid);
    { pg8::Gemm g{R0, Wcin, NP, 3072, D}; pg8::StaticOrder S; S.init(NP, 3072, G, bx);
      pg8::EpiStore<0> E{H, 3072};
      pg8::gemm_phase<pg8::EpiStore<0>, pg8::StaticOrder, true, true>(lds, g, S, E); }
    xcd_barrier(xbar);
    for (int m = gw; m < M; m += NGW) conv_row(m, H, conv_w_conv, st_conv, R1, out, lane);
    xcd_barrier(xbar);
    skinny_phase_split(R1 + (size_t)NP * D, Wout, D, ZP, bx, G, tid);
    { pg8::Gemm g{R1, Wout, NP, D, D}; pg8::StaticOrder S; S.init(NP, D, G, bx);
      pg8::EpiResid E{Z, nullptr, nullptr, R0, ALPHA};
      pg8::gemm_phase<pg8::EpiResid, pg8::StaticOrder, true, true>(lds, g, S, E); }
    xcd_barrier(xbar);
    for (int m = gw; m < M; m += NGW) { if (m < NP) ln_row<false>(Z + (size_t)m * D, ln1_g + D, ln1_b + D, R0 + (size_t)m * D, lane);
        else ln_row_sample<false, false>(ZP, m - NP, R0 + (size_t)m * D, ln1_g + D, ln1_b + D, R0 + (size_t)m * D, lane); }
    xcd_barrier(xbar);
    skinny_phase(R0 + (size_t)NP * D, Wup1, FF, D, SkStore<1>{H, FF}, bx, G, tid);
    { pg8::Gemm g{R0, Wup1, NP, FF, D}; pg8::StaticOrder S; S.init(NP, FF, G, bx);
      pg8::EpiStore<1> E{H, FF};
      pg8::gemm_phase<pg8::EpiStore<1>, pg8::StaticOrder, true, true>(lds, g, S, E); }
    xcd_barrier(xbar);
    skinny_phase_split(H + (size_t)NP * FF, Wdn1, FF, ZP, bx, G, tid);
    { pg8::Gemm g{H, Wdn1, NP, D, FF}; pg8::StaticOrder S; S.init(NP, D, G, bx);
      pg8::EpiResid E{Z, nullptr, nullptr, R0, ALPHA};
      pg8::gemm_phase<pg8::EpiResid, pg8::StaticOrder, true, true>(lds, g, S, E); }
    xcd_barrier(xbar);
    for (int m = gw; m < M; m += NGW) { if (m < NP) ln_row<true>(Z + (size_t)m * D, ln2_g + D, ln2_b + D, Z + (size_t)m * D, lane);
        else ln_row_sample<true, false>(ZP, m - NP, R0 + (size_t)m * D, ln2_g + D, ln2_b + D, Z + (size_t)m * D, lane); }
}

extern "C" void kernel_launch(void* const* d_in, const int* in_sizes, int n_in, void* d_out, int out_size, void* d_ws, size_t ws_size, hipStream_t stream) {
    static int grid = 0;
    if (grid == 0) {
        if (n_in != 18 || out_size != 35405824 || ws_size < 256 * MiB) { fprintf(stderr, "kernel_launch: unexpected shapes (n_in %d out %d ws %zu)\n", n_in, out_size, ws_size); grid = -1; return; }
        int dev = 0, cus = 0, per_cu = 0;
        hipGetDevice(&dev); hipDeviceGetAttribute(&cus, hipDeviceAttributeMultiprocessorCount, dev);
        if (hipFuncSetAttribute((const void*)mega_fwd, hipFuncAttributeMaxDynamicSharedMemorySize, LDS_BYTES) != hipSuccess) { fprintf(stderr, "kernel_launch: hipFuncSetAttribute failed\n"); grid = -1; return; }
        if (hipOccupancyMaxActiveBlocksPerMultiprocessor(&per_cu, (const void*)mega_fwd, NT, LDS_BYTES) != hipSuccess || per_cu < 1) { fprintf(stderr, "kernel_launch: occupancy query failed (%d)\n", per_cu); (void)hipGetLastError(); per_cu = 1; }
        grid = cus * (per_cu > 1 ? 1 : per_cu);
    }
    if (grid < 0) return;
    Args a{};
    for (int i = 0; i < 18; ++i) a.in[i] = (const float*)d_in[i];
    a.out = (float*)d_out; a.ws = (unsigned char*)d_ws;
    void* kargs[] = {&a};
    hipError_t e = hipLaunchCooperativeKernel((const void*)mega_fwd, dim3(grid), dim3(NT), kargs, LDS_BYTES, stream);
    if (e != hipSuccess) fprintf(stderr, "kernel_launch: cooperative launch failed: %s (grid %d)\n", hipGetErrorString(e), grid);
}
```
